# Optimizing an MI355X kernel written in HIP

```python
import jax, jax.numpy as jnp
from jax import lax
import numpy as np


D_MODEL = 2048
BATCH = 4
SEQ = 4096
DEPTH = 2

PLE_DIM = 256
EPS = 1e-6
NEG = -1e30
RET_DV = 256
RET_DK = 128
RET_HEADS = (D_MODEL // 2) // RET_DV
RET_CHUNK = 128
ATT_HD = 128
ATT_HEADS = (D_MODEL // 2) // ATT_HD
DILATED_PATTERNS = ((128, 1), (512, 4), (2048, 16))
ATT_BLOCK = 128
RET_WIDTH = RET_HEADS * RET_DV
ATT_WIDTH = ATT_HEADS * ATT_HD
MIX_WIDTH_EVEN = RET_WIDTH + ATT_WIDTH
IN_WIDTH_EVEN = 2 * RET_HEADS * RET_DK + RET_WIDTH + 3 * ATT_WIDTH + MIX_WIDTH_EVEN
CONV_WIDTH = 3
CONV_CH = D_MODEL
IN_WIDTH_ODD = 4 * CONV_CH
N_EVEN = (DEPTH + 1) // 2
N_ODD = DEPTH // 2

kernel_name = 'hybrid_retention_dilated_attn_shortconv'


def rms_norm(x, g):
    x32 = x.astype(jnp.float32)
    y = x32 * lax.rsqrt(jnp.mean(x32 * x32, axis=-1, keepdims=True) + EPS)
    return (y * g.astype(jnp.float32)).astype(x.dtype)


def alibi_slopes(n):
    start = 2.0 ** (-8.0 / n)
    return jnp.asarray(start ** np.arange(1, n + 1), dtype=jnp.float32)


def retention(q, k, v, gn_g):
    B, T, H, dk = q.shape
    dv = v.shape[-1]
    C = RET_CHUNK
    N = T // C
    f32 = jnp.float32
    log_g = jnp.asarray(np.log(1.0 - 2.0 ** (-5.0 - np.arange(H))), dtype=f32)
    pos = jnp.arange(C, dtype=f32)
    diff = pos[:, None] - pos[None, :]
    decay = jnp.where(diff >= 0, jnp.exp(log_g[:, None, None] * jnp.maximum(diff, 0.0)), 0.0)
    xi = jnp.exp(log_g[:, None] * (pos + 1.0))
    zeta = jnp.exp(log_g[:, None] * (C - 1.0 - pos))
    g_chunk = jnp.exp(log_g * C)
    qc = q.astype(f32).reshape(B, N, C, H, dk)
    kc = (k.astype(f32) * dk ** -0.5).reshape(B, N, C, H, dk)
    vc = v.astype(f32).reshape(B, N, C, H, dv)
    scores = jnp.einsum('bnchk,bnshk->bnhcs', qc, kc) * decay
    y_inner = jnp.einsum('bnhcs,bnshv->bnchv', scores, vc)
    contrib = jnp.einsum('bnshk,bnshv,hs->nbhkv', kc, vc, zeta)

    def step(R, S):
        return g_chunk[None, :, None, None] * R + S, R

    _, R_prev = lax.scan(step, jnp.zeros((B, H, dk, dv), f32), contrib)
    y_cross = jnp.einsum('bnchk,nbhkv,hc->bnchv', qc, R_prev, xi)
    y = (y_inner + y_cross).reshape(B, T, H, dv)
    mu = jnp.mean(y, axis=-1, keepdims=True)
    var = jnp.mean(jnp.square(y - mu), axis=-1, keepdims=True)
    y = (y - mu) * lax.rsqrt(var + EPS) * gn_g.astype(f32)
    return y.reshape(B, T, H * dv).astype(v.dtype)


def dilated_branch(q, k, v, window, dil, slopes):
    B, H, T, hd = q.shape
    steps = window // dil
    assert steps <= ATT_BLOCK
    L = T // dil
    nb = -(-L // ATT_BLOCK)
    Lp = nb * ATT_BLOCK

    def gather(a):
        a = a.reshape(B, H, L, dil, hd).transpose(0, 1, 3, 2, 4)
        a = jnp.pad(a, ((0, 0), (0, 0), (0, 0), (0, Lp - L), (0, 0)))
        return a.reshape(B, H, dil, nb, ATT_BLOCK, hd)

    def band(a):
        prev = jnp.pad(a[:, :, :, :-1], ((0, 0), (0, 0), (0, 0), (1, 0), (0, 0), (0, 0)))
        return jnp.concatenate([prev, a], axis=-2)

    qb = gather(q)
    kband = band(gather(k))
    vband = band(gather(v))
    s = jnp.einsum('bhrnqd,bhrnkd->bhrnqk', qb, kband)
    qi = jnp.arange(ATT_BLOCK)[:, None]
    ki = jnp.arange(2 * ATT_BLOCK)[None, :]
    rel = qi - ki + ATT_BLOCK
    blk = jnp.arange(nb)[:, None, None]
    valid = (rel >= 0) & (rel <= steps) & ((blk > 0) | (ki >= ATT_BLOCK))
    bias = -slopes[:, None, None] * (rel * dil).astype(jnp.float32)[None]
    s = jnp.where(valid[None, None, None], s + bias[None, :, None, None], NEG)
    m = jnp.max(s, axis=-1, keepdims=True)
    pr = jnp.exp(s - m)
    l = jnp.sum(pr, axis=-1)
    o = jnp.einsum('bhrnqk,bhrnkd->bhrnqd', pr, vband) / l[..., None]
    lse = m[..., 0] + jnp.log(l)
    o = o.reshape(B, H, dil, Lp, hd)[:, :, :, :L].transpose(0, 1, 3, 2, 4).reshape(B, H, T, hd)
    lse = lse.reshape(B, H, dil, Lp)[:, :, :, :L].transpose(0, 1, 3, 2).reshape(B, H, T)
    return o, lse


def dilated_attention(q, k, v, slopes):
    outs, lses = [], []
    for window, dil in DILATED_PATTERNS:
        o, lse = dilated_branch(q, k, v, window, dil, slopes)
        outs.append(o)
        lses.append(lse)
    w = jax.nn.softmax(jnp.stack(lses), axis=0)
    return jnp.einsum('gbht,gbhtd->bhtd', w, jnp.stack(outs))


def even_layer(h, w_in, q_g, k_g, gn_g, w_out, slopes):
    B, T, _ = h.shape
    rk_w = RET_HEADS * RET_DK
    offs = [rk_w, 2 * rk_w, 2 * rk_w + RET_WIDTH, 2 * rk_w + RET_WIDTH + ATT_WIDTH,
            2 * rk_w + RET_WIDTH + 2 * ATT_WIDTH, 2 * rk_w + RET_WIDTH + 3 * ATT_WIDTH]
    rq, rk, rv, aq, ak, av, z = jnp.split(h @ w_in, offs, axis=-1)
    y_ret = retention(rq.reshape(B, T, RET_HEADS, RET_DK), rk.reshape(B, T, RET_HEADS, RET_DK),
                      rv.reshape(B, T, RET_HEADS, RET_DV), gn_g)
    aq = rms_norm(aq.reshape(B, T, ATT_HEADS, ATT_HD), q_g)
    ak = rms_norm(ak.reshape(B, T, ATT_HEADS, ATT_HD), k_g)
    to_bhtd = lambda a: a.reshape(B, T, ATT_HEADS, ATT_HD).transpose(0, 2, 1, 3).astype(jnp.float32)
    y_att = dilated_attention(to_bhtd(aq) * ATT_HD ** -0.5, to_bhtd(ak), to_bhtd(av), slopes)
    y_att = y_att.transpose(0, 2, 1, 3).reshape(B, T, ATT_WIDTH).astype(h.dtype)
    y = jnp.concatenate([y_ret, y_att], axis=-1) * jax.nn.silu(z)
    return y @ w_out


def odd_layer(h, w_in, conv_w, w_out):
    bg, cg, u, z = jnp.split(h @ w_in, 4, axis=-1)
    u = cg * u
    T = u.shape[1]
    up = jnp.pad(u, ((0, 0), (CONV_WIDTH - 1, 0), (0, 0)))
    conv = sum(conv_w[j] * up[:, j:j + T] for j in range(CONV_WIDTH))
    return (bg * conv * jax.nn.silu(z)) @ w_out


def setup_inputs(seed: int = 0) -> dict:
    key = jax.random.key(seed)
    ks = jax.random.split(key, 14)
    f32 = jnp.float32

    def normal(k, shape, scale):
        return jax.random.normal(k, shape, f32) * scale

    def gain(k, shape):
        return 1.0 + 0.02 * jax.random.normal(k, shape, f32)

    return {
        'x': normal(ks[0], (BATCH, SEQ, D_MODEL), 1.0),
        'p': normal(ks[1], (DEPTH, BATCH, SEQ, PLE_DIM), 1.0),
        'pre_norm_g': gain(ks[2], (DEPTH, D_MODEL)),
        'w_in_even': normal(ks[3], (N_EVEN, D_MODEL, IN_WIDTH_EVEN), D_MODEL ** -0.5),
        'q_norm_g': gain(ks[4], (N_EVEN, ATT_HD)),
        'k_norm_g': gain(ks[5], (N_EVEN, ATT_HD)),
        'ret_gn_g': gain(ks[6], (N_EVEN, RET_HEADS, RET_DV)),
        'w_out_even': normal(ks[7], (N_EVEN, MIX_WIDTH_EVEN, D_MODEL), MIX_WIDTH_EVEN ** -0.5),
        'w_in_odd': normal(ks[8], (N_ODD, D_MODEL, IN_WIDTH_ODD), D_MODEL ** -0.5),
        'conv_w_odd': normal(ks[9], (N_ODD, CONV_WIDTH, CONV_CH), CONV_WIDTH ** -0.5),
        'w_out_odd': normal(ks[10], (N_ODD, CONV_CH, D_MODEL), CONV_CH ** -0.5),
        'ple_norm_g': gain(ks[11], (DEPTH, D_MODEL)),
        'w_ple_gate': normal(ks[12], (DEPTH, D_MODEL, D_MODEL), D_MODEL ** -0.5),
        'w_ple_proj': normal(ks[13], (DEPTH, PLE_DIM, D_MODEL), PLE_DIM ** -0.5),
    }


def reference(x, p, pre_norm_g, w_in_even, q_norm_g, k_norm_g, ret_gn_g, w_out_even,
              w_in_odd, conv_w_odd, w_out_odd, ple_norm_g, w_ple_gate, w_ple_proj):
    slopes = alibi_slopes(ATT_HEADS)
    for i in range(DEPTH):
        h = rms_norm(x, pre_norm_g[i])
        if i % 2 == 0:
            j = i // 2
            mix = even_layer(h, w_in_even[j], q_norm_g[j], k_norm_g[j], ret_gn_g[j], w_out_even[j], slopes)
        else:
            j = i // 2
            mix = odd_layer(h, w_in_odd[j], conv_w_odd[j], w_out_odd[j])
        x = x + mix
        gate = jax.nn.sigmoid(rms_norm(x, ple_norm_g[i]) @ w_ple_gate[i])
        x = x + gate * (p[i] @ w_ple_proj[i])
    return x
```

```cpp
#include <hip/hip_runtime.h>
#include <hip/hip_cooperative_groups.h>
#include <cstdio>
namespace cg = cooperative_groups;
namespace pg8 {
#define PG8_LAS __attribute__((address_space(3)))
typedef unsigned short bf16_t;
typedef short bf16x8 __attribute__((ext_vector_type(8)));
typedef float f32x4 __attribute__((ext_vector_type(4)));
typedef unsigned u32x4 __attribute__((ext_vector_type(4)));
constexpr int BM = 256, BK = 64, HALF = 128, HTB = HALF * BK * 2  , STAGE_BYTES = 8 * HTB, NXCD = 8, WGM = 8;

__host__ __device__ __forceinline__ int lds_byte(int r, int c) { const int st = (r >> 4) * 2 + (c >> 5), rr = r & 15, cc = c & 31, ob = rr * 64 + cc * 2; return st * 1024 + (ob ^ (((ob >> 9) & 1) << 5)); }
__host__ __device__ __forceinline__ void stage_rc(int b, int& R, int& C) { const int st = b / 1024, sb = b % 1024, swz = sb ^ (((sb >> 9) & 1) << 5); R = (st >> 1) * 16 + swz / 64; C = (st & 1) * 32 + (swz % 64) / 2; }
__host__ __device__ __forceinline__ int perm32(int rho) { const int n = rho >> 4, i = rho & 15; return 8 * (i >> 2) + 4 * n + (i & 3); }

struct Unit { int pm, pn; };
struct Gemm { const bf16_t* A; const bf16_t* Bt; int M, N, K; };

struct StaticOrder {
    int nM, nN, nwg, G, c;
    __host__ __device__ void init(int M, int N, int G_, int c_) { nM = M / BM; nN = N / BM; nwg = nM * nN; G = G_; c = c_; }
    __host__ __device__ bool next(int i, Unit& u) const {
        const long L = (long)i * G + c; if (L >= nwg) return false;
        int wgid = (int)L; { const int q = nwg / NXCD, r = nwg % NXCD, xcd = wgid % NXCD, off = wgid / NXCD; wgid = (xcd < r ? xcd * (q + 1) : r * (q + 1) + (xcd - r) * q) + off; }
        const int nig = WGM * nN, gid = wgid / nig, fm = gid * WGM, gsz = (nM - fm) < WGM ? (nM - fm) : WGM;
        u.pm = fm + ((wgid % nig) % gsz); u.pn = (wgid % nig) / gsz; return true;
    }
    __device__ __forceinline__ void a_ready(const Unit&) const {}
    __device__ __forceinline__ void done(const Unit&) const {}
};
__device__ __forceinline__ unsigned cvt_pk_bf16(float lo, float hi) { unsigned r; asm volatile("v_cvt_pk_bf16_f32 %0, %1, %2" : "=v"(r) : "v"(lo), "v"(hi)); return r; }
typedef float f32x2 __attribute__((ext_vector_type(2)));
typedef unsigned u32x2 __attribute__((ext_vector_type(2)));
struct EpiScaleBf16 {
    static constexpr bool PERM = true, AFTER_DRAIN = false;
    bf16_t* O; int ldc; const float* rs;
    __device__ __forceinline__ void operator()(const f32x4 (&acc)[2][2][4][2], const Unit& u, int wr, int wc, int fr, int fq) const {
        const int row0 = u.pm * BM + wr * 64 + fr, col0 = u.pn * BM + wc * 32 + 8 * fq;
#pragma unroll
        for (int ai = 0; ai < 2; ++ai)
#pragma unroll
            for (int m = 0; m < 4; ++m) { const int row = row0 + ai * HALF + m * 16;
                const float sc = rs ? rsqrtf(rs[row] * (1.0f / 2048.0f) + 1e-6f) : 1.0f;
                bf16_t* rowp = O + (size_t)row * ldc + col0;
#pragma unroll
                for (int bj = 0; bj < 2; ++bj) { const f32x4 v0 = acc[ai][bj][m][0] * sc, v1 = acc[ai][bj][m][1] * sc;
                    u32x4 w; w.x = cvt_pk_bf16(v0[0], v0[1]); w.y = cvt_pk_bf16(v0[2], v0[3]); w.z = cvt_pk_bf16(v1[0], v1[1]); w.w = cvt_pk_bf16(v1[2], v1[3]);
                    *(u32x4*)(rowp + bj * HALF) = w; } }
    }
};
struct EpiResid {
    static constexpr bool PERM = false, AFTER_DRAIN = false;
    const float* xin; float* xout; bf16_t* xg; const float* g; float* rs;
    __device__ __forceinline__ void operator()(const f32x4 (&acc)[2][2][4][2], const Unit& u, int wr, int wc, int fr, int fq) const {
        const int row0 = u.pm * BM + wr * 64 + fr, col0 = u.pn * BM + wc * 32 + 4 * fq;
        f32x4 gv[2][2];
#pragma unroll
        for (int bj = 0; bj < 2; ++bj)
#pragma unroll
            for (int n = 0; n < 2; ++n) gv[bj][n] = *(const f32x4*)(g + col0 + bj * HALF + n * 16);
#pragma unroll
        for (int ai = 0; ai < 2; ++ai)
#pragma unroll
            for (int m = 0; m < 4; ++m) { const int row = row0 + ai * HALF + m * 16; const size_t off = (size_t)row * 2048 + col0; float s = 0.f;
#pragma unroll
                for (int bj = 0; bj < 2; ++bj)
#pragma unroll
                    for (int n = 0; n < 2; ++n) { const f32x4 xi = *(const f32x4*)(xin + off + bj * HALF + n * 16); const f32x4 xn = xi + acc[ai][bj][m][n];
                        *(f32x4*)(xout + off + bj * HALF + n * 16) = xn; s += (xn[0] * xn[0] + xn[1] * xn[1]) + (xn[2] * xn[2] + xn[3] * xn[3]);
                        const f32x4 t = xn * gv[bj][n]; u32x2 w; w.x = cvt_pk_bf16(t[0], t[1]); w.y = cvt_pk_bf16(t[2], t[3]);
                        *(u32x2*)(xg + off + bj * HALF + n * 16) = w; }
                s += __shfl_xor(s, 16); s += __shfl_xor(s, 32);
                if (fq == 0) atomicAdd(rs + row, s);
                asm volatile("" ::: "memory"); }
    }
};
struct EpiGate {
    static constexpr bool PERM = false, AFTER_DRAIN = false;
    const float* rs_in; const bf16_t* pp; float* xio; bf16_t* xg; const float* g; float* rs_out;
    __device__ __forceinline__ void operator()(const f32x4 (&acc)[2][2][4][2], const Unit& u, int wr, int wc, int fr, int fq) const {
        const int row0 = u.pm * BM + wr * 64 + fr, col0 = u.pn * BM + wc * 32 + 4 * fq;
        f32x4 gv[2][2];
#pragma unroll
        for (int bj = 0; bj < 2; ++bj)
#pragma unroll
            for (int n = 0; n < 2; ++n) gv[bj][n] = xg ? *(const f32x4*)(g + col0 + bj * HALF + n * 16) : (f32x4){0.f, 0.f, 0.f, 0.f};
#pragma unroll
        for (int ai = 0; ai < 2; ++ai)
#pragma unroll
            for (int m = 0; m < 4; ++m) { const int row = row0 + ai * HALF + m * 16; const size_t off = (size_t)row * 2048 + col0; float s = 0.f;
                const float sc = rsqrtf(rs_in[row] * (1.0f / 2048.0f) + 1e-6f);
#pragma unroll
                for (int bj = 0; bj < 2; ++bj)
#pragma unroll
                    for (int n = 0; n < 2; ++n) { const size_t o = off + bj * HALF + n * 16;
                        const f32x4 xi = *(const f32x4*)(xio + o); const u32x2 pw = *(const u32x2*)(pp + o);
                        const f32x4 a = acc[ai][bj][m][n] * sc; f32x4 pv;
                        pv[0] = __uint_as_float(pw.x << 16); pv[1] = __uint_as_float(pw.x & 0xffff0000u); pv[2] = __uint_as_float(pw.y << 16); pv[3] = __uint_as_float(pw.y & 0xffff0000u);
                        f32x4 xn;
#pragma unroll
                        for (int j = 0; j < 4; ++j) xn[j] = xi[j] + pv[j] / (1.0f + __expf(-a[j]));
                        *(f32x4*)(xio + o) = xn;
                        if (xg) { s += (xn[0] * xn[0] + xn[1] * xn[1]) + (xn[2] * xn[2] + xn[3] * xn[3]);
                            const f32x4 t = xn * gv[bj][n]; u32x2 w; w.x = cvt_pk_bf16(t[0], t[1]); w.y = cvt_pk_bf16(t[2], t[3]);
                            *(u32x2*)(xg + o) = w; } }
                if (xg) { s += __shfl_xor(s, 16); s += __shfl_xor(s, 32); if (fq == 0) atomicAdd(rs_out + row, s); }
                asm volatile("" ::: "memory"); }
    }
};
template <class Epi, class Sched, bool STAMP = false>
__device__ __forceinline__ void gemm_phase(PG8_LAS unsigned char* lds, const Gemm g, const Sched& S, const Epi& E, unsigned long long* stamps) {
    int tid_ = threadIdx.x; asm volatile("" : "+v"(tid_));
    const int tid = tid_, wid = __builtin_amdgcn_readfirstlane(tid >> 6), lane = tid & 63, wr = wid >> 2, wc = wid & 3, fr = lane & 15, fq = lane >> 4;
    const int K = g.K, nt = K / BK;
    int ts_lo = 0, ts_hi = 0, nts = 0; const unsigned long long rt_entry = STAMP ? (unsigned long long)wall_clock64() : 0ull;
#define PG8_STAMP() do { if (STAMP && wid == 0 && nts < 64) { const unsigned long long _c = (unsigned long long)clock64(); \
        ts_lo = (lane == nts) ? (int)(unsigned)_c : ts_lo; ts_hi = (lane == nts) ? (int)(unsigned)(_c >> 32) : ts_hi; ++nts; } } while (0)
    PG8_STAMP();
    unsigned voffA[2], voffB[2];
#pragma unroll
    for (int i = 0; i < 2; ++i) { int R, C; stage_rc(tid * 16 + i * 8192, R, C); const int Rb = Epi::PERM ? ((R & ~31) + perm32(R & 31)) : R;
        voffA[i] = (unsigned)(R * K + C) * 2u; voffB[i] = (unsigned)(Rb * K + C) * 2u; }
    const size_t kstep = (size_t)(BK * 2);
    const size_t hstep = (size_t)HALF * K * 2;
    const size_t tstep = 2 * hstep;
    const unsigned ldsw = (unsigned)wid * 1024u;
    const int aoff = lds_byte(wr * 64 + fr, fq * 8), boff = lds_byte(wc * 32 + fr, fq * 8);
#define PG8_SA(b, h) (((b) * 2 + (h)) * HTB)
#define PG8_SB(b, h) ((4 + (b) * 2 + (h)) * HTB)
#define PG8_STAGE(bufoff, gbase, voff) do { _Pragma("unroll") for (int _i = 0; _i < 2; ++_i) \
        __builtin_amdgcn_global_load_lds((const unsigned*)((const char*)(gbase) + (voff)[_i]), (PG8_LAS unsigned*)(lds + (bufoff) + ldsw + _i * 8192), 16, 0, 0); } while (0)
#define PG8_LDA(dst, b, h) do { _Pragma("unroll") for (int m = 0; m < 4; ++m) _Pragma("unroll") for (int k = 0; k < 2; ++k) dst[m][k] = *(const PG8_LAS bf16x8*)(lds + PG8_SA(b, h) + aoff + m * 2048 + k * 1024); } while (0)
#define PG8_LDB(dst, b, h) do { _Pragma("unroll") for (int n = 0; n < 2; ++n) _Pragma("unroll") for (int k = 0; k < 2; ++k) dst[n][k] = *(const PG8_LAS bf16x8*)(lds + PG8_SB(b, h) + boff + n * 2048 + k * 1024); } while (0)
#define PG8_MMA(ai, bj, At, Bt) do { __builtin_amdgcn_s_setprio(1); _Pragma("unroll") for (int m = 0; m < 4; ++m) _Pragma("unroll") for (int n = 0; n < 2; ++n) _Pragma("unroll") for (int k = 0; k < 2; ++k) \
        acc[ai][bj][m][n] = __builtin_amdgcn_mfma_f32_16x16x32_bf16(Bt[n][k], At[m][k], acc[ai][bj][m][n], 0, 0, 0); __builtin_amdgcn_s_setprio(0); } while (0)
#define PG8_WAIT_V(n) asm volatile("s_waitcnt vmcnt(" #n ")" ::: "memory")
#define PG8_WAIT_L(n) asm volatile("s_waitcnt lgkmcnt(" #n ")" ::: "memory")
#define PG8_BAR __builtin_amdgcn_s_barrier()
#define PG8_SCHED __builtin_amdgcn_sched_barrier(0)
    Unit cur, nxt; int ui = 0;
    if (!S.next(0, cur)) return;
    f32x4 acc[2][2][4][2];
#pragma unroll
    for (int a = 0; a < 2; ++a)
#pragma unroll
        for (int b = 0; b < 2; ++b)
#pragma unroll
            for (int m = 0; m < 4; ++m)
#pragma unroll
                for (int n = 0; n < 2; ++n) acc[a][b][m][n] = (f32x4){0.f, 0.f, 0.f, 0.f};
    bf16x8 At[4][2], B0[2][2], B1[2][2];
    const char* cA = (const char*)g.A + (size_t)cur.pm * tstep; const char* cB = (const char*)g.Bt + (size_t)cur.pn * tstep;
    S.a_ready(cur);
    PG8_STAGE(PG8_SB(0, 0), cB, voffB); PG8_STAGE(PG8_SA(0, 0), cA, voffA); PG8_STAGE(PG8_SB(0, 1), cB + hstep, voffB); PG8_STAGE(PG8_SA(0, 1), cA + hstep, voffA);
    if (wr == 1) PG8_BAR;
    PG8_WAIT_V(4); PG8_BAR;
    PG8_STAGE(PG8_SB(1, 0), cB + kstep, voffB); PG8_STAGE(PG8_SA(1, 0), cA + kstep, voffA); PG8_STAGE(PG8_SB(1, 1), cB + hstep + kstep, voffB);
    PG8_WAIT_V(6); PG8_BAR;
    PG8_STAMP();
    for (;;) {
        const bool has_next = S.next(ui + 1, nxt);
        const char* nA = has_next ? (const char*)g.A + (size_t)nxt.pm * tstep : cA; const char* nB = has_next ? (const char*)g.Bt + (size_t)nxt.pn * tstep : cB;
        for (int t = 0; t < nt; t += 2) {
            const bool last = (t == nt - 2);
            const char* a1 = cA + (size_t)(t + 1) * kstep;
            const char* a2 = last ? nA : cA + (size_t)(t + 2) * kstep; const char* b2 = last ? nB : cB + (size_t)(t + 2) * kstep;
            const char* a3 = a2 + kstep; const char* b3 = b2 + kstep;
            if (last && has_next) S.a_ready(nxt);
            PG8_LDB(B0, 0, 0); PG8_SCHED; PG8_LDA(At, 0, 0); PG8_STAGE(PG8_SA(1, 1), a1 + hstep, voffA);
            PG8_WAIT_L(8); PG8_BAR; PG8_WAIT_L(0); PG8_MMA(0, 0, At, B0); PG8_BAR; PG8_SCHED;
            PG8_LDB(B1, 0, 1); PG8_STAGE(PG8_SB(0, 0), b2, voffB);
            PG8_BAR; PG8_WAIT_L(0); PG8_MMA(0, 1, At, B1); PG8_BAR;
            PG8_LDA(At, 0, 1); PG8_STAGE(PG8_SA(0, 0), a2, voffA);
            PG8_BAR; PG8_WAIT_L(0); PG8_MMA(1, 0, At, B0); PG8_BAR; PG8_SCHED;
            PG8_STAGE(PG8_SB(0, 1), b2 + hstep, voffB);
            PG8_WAIT_V(6); PG8_BAR; PG8_MMA(1, 1, At, B1); PG8_BAR;
            PG8_LDB(B0, 1, 0); PG8_SCHED; PG8_LDA(At, 1, 0); PG8_STAGE(PG8_SA(0, 1), a2 + hstep, voffA);
            PG8_WAIT_L(8); PG8_BAR; PG8_WAIT_L(0); PG8_MMA(0, 0, At, B0); PG8_BAR; PG8_SCHED;
            PG8_LDB(B1, 1, 1); PG8_STAGE(PG8_SB(1, 0), b3, voffB);
            PG8_BAR; PG8_WAIT_L(0); PG8_MMA(0, 1, At, B1); PG8_BAR;
            PG8_LDA(At, 1, 1); PG8_STAGE(PG8_SA(1, 0), a3, voffA);
            PG8_BAR; PG8_WAIT_L(0); PG8_MMA(1, 0, At, B0); PG8_BAR; PG8_SCHED;
            PG8_STAGE(PG8_SB(1, 1), b3 + hstep, voffB);
            PG8_WAIT_V(6); PG8_BAR; PG8_MMA(1, 1, At, B1); PG8_BAR;
        }
        PG8_STAMP();
        if constexpr (!Epi::AFTER_DRAIN) { E(acc, cur, wr, wc, fr, fq); S.done(cur); }
        PG8_STAMP();
        if (!has_next) break;
#pragma unroll
        for (int a = 0; a < 2; ++a)
#pragma unroll
            for (int b = 0; b < 2; ++b)
#pragma unroll
                for (int m = 0; m < 4; ++m)
#pragma unroll
                    for (int n = 0; n < 2; ++n) acc[a][b][m][n] = (f32x4){0.f, 0.f, 0.f, 0.f};
        cur = nxt; cA = nA; cB = nB; ++ui;
    }
    PG8_WAIT_V(0);
    if (wr == 0) PG8_BAR;
    PG8_BAR;
    if constexpr (Epi::AFTER_DRAIN) { E.fused(acc, cur, wr, wc, fr, fq, lds, wid, lane); S.done(cur); }
    PG8_STAMP();
    if (STAMP && wid == 0) { stamps[lane] = lane < nts ? (((unsigned long long)(unsigned)ts_hi << 32) | (unsigned)ts_lo) : 0ull;
        if (lane == 62) stamps[62] = rt_entry; if (lane == 63) stamps[63] = (unsigned long long)wall_clock64(); }
#undef PG8_STAMP
#undef PG8_SA
#undef PG8_SB
#undef PG8_STAGE
#undef PG8_LDA
#undef PG8_LDB
#undef PG8_MMA
#undef PG8_WAIT_V
#undef PG8_WAIT_L
#undef PG8_BAR
#undef PG8_SCHED
}
}
#define LAS __attribute__((address_space(3)))
typedef unsigned short u16;
typedef unsigned int u32;
typedef pg8::bf16x8 bf16x8;
typedef pg8::f32x4 f32x4;
typedef pg8::u32x4 u32x4;
typedef pg8::u32x2 u32x2;
using pg8::cvt_pk_bf16;

constexpr int MROWS = 16384, DM = 2048, SEQ = 4096;
constexpr int NE = 7168, NO = 8192;
constexpr float EPSF = 1e-6f;
constexpr int LDS_BYTES = 139264;

constexpr size_t WS_WT_IN  = 0;
constexpr size_t WS_WT_O0  = WS_WT_IN + (size_t)8192 * 2048 * 2;
constexpr size_t WS_WT_O1  = WS_WT_O0 + (size_t)2048 * 2048 * 2;
constexpr size_t WS_WT_G0  = WS_WT_O1 + (size_t)2048 * 2048 * 2;
constexpr size_t WS_WT_G1  = WS_WT_G0 + (size_t)2048 * 2048 * 2;
constexpr size_t WS_WT_P0  = WS_WT_G1 + (size_t)2048 * 2048 * 2;
constexpr size_t WS_WT_P1  = WS_WT_P0 + (size_t)2048 * 256 * 2;
constexpr size_t WS_PROJ   = WS_WT_P1 + (size_t)2048 * 256 * 2;
constexpr size_t WS_XA     = WS_PROJ + (size_t)16384 * 8192 * 2;
constexpr size_t WS_XB     = WS_XA + (size_t)16384 * 2048 * 2;
constexpr size_t WS_PBF    = WS_XB + (size_t)16384 * 2048 * 2;
constexpr size_t WS_RS     = WS_PBF + (size_t)2 * 16384 * 256 * 2;
constexpr size_t WS_LSE    = WS_RS + (size_t)4 * 16384 * 4;
constexpr size_t WS_END    = WS_LSE + (size_t)3 * 16384 * 8 * 4;

#ifndef EN_P0
#define EN_P0 1
#endif
#ifndef EN_P2
#define EN_P2 1
#endif
#ifndef EN_P3
#define EN_P3 1
#endif
#ifndef EN_P4
#define EN_P4 1
#endif
#ifndef EN_P8
#define EN_P8 1
#endif
#ifndef EN_GR
#define EN_GR 1
#endif
#ifndef EN_GS
#define EN_GS 1
#endif
#ifndef EN_GG
#define EN_GG 1
#endif
struct Params { const float* in[14]; float* out; unsigned char* ws; int ph_lo, ph_hi; };

__device__ __forceinline__ float bflo(u32 w) { return __uint_as_float(w << 16); }
__device__ __forceinline__ float bfhi(u32 w) { return __uint_as_float(w & 0xffff0000u); }
__device__ __forceinline__ void unpack8(const u32x4 w, float (&f)[8]) { f[0] = bflo(w.x); f[1] = bfhi(w.x); f[2] = bflo(w.y); f[3] = bfhi(w.y); f[4] = bflo(w.z); f[5] = bfhi(w.z); f[6] = bflo(w.w); f[7] = bfhi(w.w); }
__device__ __forceinline__ u32x4 pack8(const float (&f)[8]) { u32x4 w; w.x = cvt_pk_bf16(f[0], f[1]); w.y = cvt_pk_bf16(f[2], f[3]); w.z = cvt_pk_bf16(f[4], f[5]); w.w = cvt_pk_bf16(f[6], f[7]); return w; }
__device__ __forceinline__ float silu_f(float z) { return z / (1.0f + __expf(-z)); }
__device__ __forceinline__ f32x4 mfma16(bf16x8 a, bf16x8 b, f32x4 c) { return __builtin_amdgcn_mfma_f32_16x16x32_bf16(a, b, c, 0, 0, 0); }

__device__ __forceinline__ void transpose_item(const float* __restrict__ W, int K, int N, u16* __restrict__ WT, LAS float* scr, int item, int tid) {
    asm volatile("" : "+v"(tid));
    const int nblk = N >> 6, kb = item / nblk, nb = item - kb * nblk, k0 = kb << 6, n0 = nb << 6;
    const int ty = tid >> 4, tx = tid & 15;
#pragma unroll
    for (int i = 0; i < 2; ++i) { const int kk = ty + 32 * i; const f32x4 v = *(const f32x4*)(W + (size_t)(k0 + kk) * N + n0 + 4 * tx);
        scr[kk * 65 + 4 * tx + 0] = v[0]; scr[kk * 65 + 4 * tx + 1] = v[1]; scr[kk * 65 + 4 * tx + 2] = v[2]; scr[kk * 65 + 4 * tx + 3] = v[3]; }
    __syncthreads();
    const int n = tid >> 3, c = tid & 7; const LAS float* s = scr + (8 * c) * 65 + n;
    u32x4 o; o.x = cvt_pk_bf16(s[0], s[65]); o.y = cvt_pk_bf16(s[2 * 65], s[3 * 65]); o.z = cvt_pk_bf16(s[4 * 65], s[5 * 65]); o.w = cvt_pk_bf16(s[6 * 65], s[7 * 65]);
    *(u32x4*)(WT + (size_t)(n0 + n) * K + k0 + 8 * c) = o;
    __syncthreads();
}

__device__ __forceinline__ void attn_item(LAS unsigned char* lds, const u16* __restrict__ proj, u16* __restrict__ og, float* __restrict__ lse,
                                          const float* __restrict__ qg, const float* __restrict__ kg, int item, int tid, int wid, int lane) {
    asm volatile("" : "+v"(lane), "+v"(tid));
    const int fr = lane & 15, fq = lane >> 4;
    const int g = item >> 10, rem = item & 1023, b = rem >> 8, h = (rem >> 5) & 7, u = rem & 31;
    const int dil = (g == 0) ? 1 : (g == 1 ? 4 : 16);
    const int nb = 32 / dil;
    const int r = u / nb, n = u - r * nb;
    const float slope = exp2f(-(float)(h + 1));
    const size_t rowbase = (size_t)b * SEQ;
    const u16* qbase = proj + rowbase * NE + 2048 + h * 128;
    const u16* kbase = proj + rowbase * NE + 3072 + h * 128;
    const u16* vbase = proj + rowbase * NE + 4096 + h * 128;
    LAS unsigned char* Ks = lds;
    LAS unsigned char* Vt = lds + 69632;
    __syncthreads();
    {
        const int pc = tid & 15;
        float kgv[8];
#pragma unroll
        for (int j = 0; j < 8; ++j) kgv[j] = kg[pc * 8 + j];
#pragma unroll 2
        for (int i = 0; i < 8; ++i) {
            const int row = (tid >> 4) + 32 * i;
            int sidx = n * 128 - 128 + row; if (sidx < 0) sidx = 0;
            const size_t t = (size_t)r + (size_t)sidx * dil;
            const u32x4 kw = *(const u32x4*)(kbase + t * NE + pc * 8);
            const u32x4 vw = *(const u32x4*)(vbase + t * NE + pc * 8);
            float kf[8]; unpack8(kw, kf);
            float ss = 0.f;
#pragma unroll
            for (int j = 0; j < 8; ++j) ss += kf[j] * kf[j];
            ss += __shfl_xor(ss, 1); ss += __shfl_xor(ss, 2); ss += __shfl_xor(ss, 4); ss += __shfl_xor(ss, 8);
            const float rstd = rsqrtf(ss * (1.0f / 128.0f) + EPSF);
#pragma unroll
            for (int j = 0; j < 8; ++j) kf[j] = kf[j] * rstd * kgv[j];
            *(LAS u32x4*)(Ks + row * 272 + pc * 16) = pack8(kf);
            LAS unsigned char* vp = Vt + (pc * 8) * 528 + row * 2;
            *(LAS u16*)(vp + 0 * 528) = (u16)(vw.x & 0xffff); *(LAS u16*)(vp + 1 * 528) = (u16)(vw.x >> 16);
            *(LAS u16*)(vp + 2 * 528) = (u16)(vw.y & 0xffff); *(LAS u16*)(vp + 3 * 528) = (u16)(vw.y >> 16);
            *(LAS u16*)(vp + 4 * 528) = (u16)(vw.z & 0xffff); *(LAS u16*)(vp + 5 * 528) = (u16)(vw.z >> 16);
            *(LAS u16*)(vp + 6 * 528) = (u16)(vw.w & 0xffff); *(LAS u16*)(vp + 7 * 528) = (u16)(vw.w >> 16);
        }
    }
    const int qi = 16 * wid + fr;
    const size_t tq = (size_t)r + (size_t)(n * 128 + qi) * dil;
    bf16x8 qf[4];
    {
        const u16* qp = qbase + tq * NE;
        float qv[4][8]; float ss = 0.f;
#pragma unroll
        for (int ks = 0; ks < 4; ++ks) { const u32x4 w = *(const u32x4*)(qp + 32 * ks + 8 * fq); unpack8(w, qv[ks]);
#pragma unroll
            for (int j = 0; j < 8; ++j) ss += qv[ks][j] * qv[ks][j]; }
        ss += __shfl_xor(ss, 16); ss += __shfl_xor(ss, 32);
        const float qs = rsqrtf(ss * (1.0f / 128.0f) + EPSF) * 0.08838834764831845f;
#pragma unroll
        for (int ks = 0; ks < 4; ++ks) { float t[8];
#pragma unroll
            for (int j = 0; j < 8; ++j) t[j] = qv[ks][j] * qs * qg[32 * ks + 8 * fq + j];
            qf[ks] = __builtin_bit_cast(bf16x8, pack8(t)); }
    }
    __syncthreads();
    const int kt0 = 2 * (wid >> 1);
    f32x4 s[10];
#pragma unroll
    for (int j = 0; j < 10; ++j) { f32x4 acc = {0.f, 0.f, 0.f, 0.f};
#pragma unroll
        for (int ks = 0; ks < 4; ++ks) { const bf16x8 kf = *(const LAS bf16x8*)(Ks + (16 * (kt0 + j) + fr) * 272 + (32 * ks + 8 * fq) * 2); acc = mfma16(kf, qf[ks], acc); }
        s[j] = acc; __builtin_amdgcn_sched_barrier(0); }
    float mx = -3.0e38f;
#pragma unroll
    for (int j = 0; j < 10; ++j)
#pragma unroll
        for (int i = 0; i < 4; ++i) { const int ki = 16 * (kt0 + j) + 4 * fq + i; const int rel = qi - ki + 128;
            const bool valid = (rel >= 0) && (rel <= 128) && ((n > 0) || (ki >= 128));
            const float v = valid ? s[j][i] - slope * (float)(rel * dil) : -1.0e30f; s[j][i] = v; mx = fmaxf(mx, v); }
    mx = fmaxf(mx, __shfl_xor(mx, 16)); mx = fmaxf(mx, __shfl_xor(mx, 32));
    float l = 0.f;
#pragma unroll
    for (int j = 0; j < 10; ++j)
#pragma unroll
        for (int i = 0; i < 4; ++i) { const float p = __expf(s[j][i] - mx); s[j][i] = p; l += p; }
    l += __shfl_xor(l, 16); l += __shfl_xor(l, 32);
    __syncthreads();
    LAS unsigned char* Ps = lds;
#pragma unroll
    for (int j = 0; j < 10; ++j) { u32x2 w; w.x = cvt_pk_bf16(s[j][0], s[j][1]); w.y = cvt_pk_bf16(s[j][2], s[j][3]);
        *(LAS u32x2*)(Ps + qi * 528 + (16 * (kt0 + j) + 4 * fq) * 2) = w; }
    __syncthreads();
    f32x4 o[8];
#pragma unroll
    for (int dt = 0; dt < 8; ++dt) o[dt] = (f32x4){0.f, 0.f, 0.f, 0.f};
#pragma unroll
    for (int k5 = 0; k5 < 5; ++k5) { const int key0 = 16 * kt0 + 32 * k5 + 8 * fq;
        const bf16x8 pf = *(const LAS bf16x8*)(Ps + qi * 528 + key0 * 2);
#pragma unroll
        for (int dt = 0; dt < 8; ++dt) { const bf16x8 vf = *(const LAS bf16x8*)(Vt + (16 * dt + fr) * 528 + key0 * 2); o[dt] = mfma16(vf, pf, o[dt]); } __builtin_amdgcn_sched_barrier(0); }
    const float inv = 1.0f / l;
    const size_t orow = (size_t)g * MROWS + rowbase + tq;
    u16* op = og + orow * 1024 + h * 128 + 4 * fq;
#pragma unroll
    for (int dt = 0; dt < 8; ++dt) { u32x2 w; w.x = cvt_pk_bf16(o[dt][0] * inv, o[dt][1] * inv); w.y = cvt_pk_bf16(o[dt][2] * inv, o[dt][3] * inv); *(u32x2*)(op + 16 * dt) = w; }
    if (fq == 0) lse[orow * 8 + h] = mx + __logf(l);
}

__device__ __forceinline__ float ret_log_g(int h) { return __logf(1.0f - exp2f(-5.0f - (float)h)); }

__device__ __forceinline__ void ret_contrib_item(LAS unsigned char* lds, const u16* __restrict__ proj, float* __restrict__ ST, int item, int tid, int wid, int lane) {
    asm volatile("" : "+v"(lane), "+v"(tid));
    const int fr = lane & 15, fq = lane >> 4;
    const int bh = item >> 5, n = item & 31, b = bh >> 2, h = bh & 3;
    const size_t row0 = (size_t)b * SEQ + (size_t)n * 128;
    const u16* kbase = proj + row0 * NE + 512 + h * 128;
    const u16* vbase = proj + row0 * NE + 1024 + h * 256;
    const float lg = ret_log_g(h);
    LAS unsigned char* Kt = lds;
    LAS unsigned char* Vt = lds + 34816;
    __syncthreads();
#pragma unroll 2
    for (int i = 0; i < 4; ++i) { const int p = tid + 512 * i, sI = p >> 4, pc = p & 15;
        const u32x4 w = *(const u32x4*)(kbase + (size_t)sI * NE + pc * 8);
        const float zs = __expf(lg * (float)(127 - sI)) * 0.08838834764831845f;
        float f[8]; unpack8(w, f);
        LAS unsigned char* kp = Kt + (pc * 8) * 272 + sI * 2;
#pragma unroll
        for (int j = 0; j < 8; j += 2) { const u32 pk = cvt_pk_bf16(f[j] * zs, f[j + 1] * zs); *(LAS u16*)(kp + j * 272) = (u16)(pk & 0xffff); *(LAS u16*)(kp + (j + 1) * 272) = (u16)(pk >> 16); } }
#pragma unroll 2
    for (int i = 0; i < 8; ++i) { const int p = tid + 512 * i, sI = p >> 5, pc = p & 31;
        const u32x4 w = *(const u32x4*)(vbase + (size_t)sI * NE + pc * 8);
        LAS unsigned char* vp = Vt + (pc * 8) * 272 + sI * 2;
        *(LAS u16*)(vp + 0 * 272) = (u16)(w.x & 0xffff); *(LAS u16*)(vp + 1 * 272) = (u16)(w.x >> 16);
        *(LAS u16*)(vp + 2 * 272) = (u16)(w.y & 0xffff); *(LAS u16*)(vp + 3 * 272) = (u16)(w.y >> 16);
        *(LAS u16*)(vp + 4 * 272) = (u16)(w.z & 0xffff); *(LAS u16*)(vp + 5 * 272) = (u16)(w.z >> 16);
        *(LAS u16*)(vp + 6 * 272) = (u16)(w.w & 0xffff); *(LAS u16*)(vp + 7 * 272) = (u16)(w.w >> 16); }
    __syncthreads();
    f32x4 acc[2][8];
#pragma unroll
    for (int mt = 0; mt < 2; ++mt)
#pragma unroll
        for (int nt = 0; nt < 8; ++nt) acc[mt][nt] = (f32x4){0.f, 0.f, 0.f, 0.f};
#pragma unroll
    for (int ks = 0; ks < 4; ++ks) { bf16x8 vf[2];
#pragma unroll
        for (int mt = 0; mt < 2; ++mt) vf[mt] = *(const LAS bf16x8*)(Vt + (32 * wid + 16 * mt + fr) * 272 + (32 * ks + 8 * fq) * 2);
#pragma unroll
        for (int nt = 0; nt < 8; ++nt) { const bf16x8 kf = *(const LAS bf16x8*)(Kt + (16 * nt + fr) * 272 + (32 * ks + 8 * fq) * 2);
#pragma unroll
            for (int mt = 0; mt < 2; ++mt) acc[mt][nt] = mfma16(kf, vf[mt], acc[mt][nt]); } __builtin_amdgcn_sched_barrier(0); }
    float* out = ST + (size_t)item * 32768;
#pragma unroll
    for (int mt = 0; mt < 2; ++mt)
#pragma unroll
        for (int nt = 0; nt < 8; ++nt) *(f32x4*)(out + (32 * wid + 16 * mt + fr) * 128 + 16 * nt + 4 * fq) = acc[mt][nt];
}

__device__ __forceinline__ void ret_out_item(LAS unsigned char* lds, const u16* __restrict__ proj, const u16* __restrict__ RT, const float* __restrict__ gn, u16* __restrict__ y0,
                                             int item, int tid, int wid, int lane) {
    asm volatile("" : "+v"(lane), "+v"(tid));
    const int fr = lane & 15, fq = lane >> 4;
    const int bh = item >> 5, n = item & 31, b = bh >> 2, h = bh & 3;
    const size_t row0 = (size_t)b * SEQ + (size_t)n * 128;
    const u16* qbase = proj + row0 * NE + h * 128;
    const u16* kbase = proj + row0 * NE + 512 + h * 128;
    const u16* vbase = proj + row0 * NE + 1024 + h * 256;
    const u16* zbase = proj + row0 * NE + 5120 + h * 256;
    const u16* rtb = RT + (size_t)item * 32768;
    const float lg = ret_log_g(h);
    LAS unsigned char* Ks = lds;
    LAS unsigned char* Ps = lds + 34816;
    LAS unsigned char* Vh = lds + 69632;
    LAS unsigned char* Rh = lds + 104448;
    __syncthreads();
#pragma unroll
    for (int i = 0; i < 4; ++i) { const int p = tid + 512 * i, sI = p >> 4, pc = p & 15;
        *(LAS u32x4*)(Ks + sI * 272 + pc * 16) = *(const u32x4*)(kbase + (size_t)sI * NE + pc * 8); }
    const int c = 16 * wid + fr;
    bf16x8 qf[4], qx[4];
    {
        const u16* qp = qbase + (size_t)c * NE; const float xi = __expf(lg * (float)(c + 1));
#pragma unroll
        for (int ks = 0; ks < 4; ++ks) { const u32x4 w = *(const u32x4*)(qp + 32 * ks + 8 * fq); qf[ks] = __builtin_bit_cast(bf16x8, w);
            float f[8]; unpack8(w, f);
#pragma unroll
            for (int j = 0; j < 8; ++j) f[j] *= xi;
            qx[ks] = __builtin_bit_cast(bf16x8, pack8(f)); }
    }
    __syncthreads();
#pragma unroll
    for (int st = 0; st < 8; ++st) {
        u32x2 w; w.x = 0u; w.y = 0u;
        if (st <= wid) { f32x4 acc = {0.f, 0.f, 0.f, 0.f};
#pragma unroll
            for (int ks = 0; ks < 4; ++ks) { const bf16x8 kf = *(const LAS bf16x8*)(Ks + (16 * st + fr) * 272 + (32 * ks + 8 * fq) * 2); acc = mfma16(kf, qf[ks], acc); }
            float pv[4];
#pragma unroll
            for (int i = 0; i < 4; ++i) { const int d = c - (16 * st + 4 * fq + i); pv[i] = (d >= 0) ? acc[i] * 0.08838834764831845f * __expf(lg * (float)d) : 0.f; }
            w.x = cvt_pk_bf16(pv[0], pv[1]); w.y = cvt_pk_bf16(pv[2], pv[3]); }
        *(LAS u32x2*)(Ps + c * 272 + (16 * st + 4 * fq) * 2) = w; __builtin_amdgcn_sched_barrier(0);
    }
    f32x4 y[2][8];
#pragma unroll
    for (int hf = 0; hf < 2; ++hf)
#pragma unroll
        for (int vt = 0; vt < 8; ++vt) y[hf][vt] = (f32x4){0.f, 0.f, 0.f, 0.f};
#pragma unroll
    for (int hf = 0; hf < 2; ++hf) {
        __syncthreads();
        int hoff = 128 * hf; asm volatile("" : "+v"(hoff));
#pragma unroll 2
        for (int i = 0; i < 4; ++i) { const int p = tid + 512 * i, sI = p >> 4, pc = p & 15;
            const u32x4 w = *(const u32x4*)(vbase + (size_t)sI * NE + hoff + pc * 8);
            LAS unsigned char* vp = Vh + (pc * 8) * 272 + sI * 2;
            *(LAS u16*)(vp + 0 * 272) = (u16)(w.x & 0xffff); *(LAS u16*)(vp + 1 * 272) = (u16)(w.x >> 16);
            *(LAS u16*)(vp + 2 * 272) = (u16)(w.y & 0xffff); *(LAS u16*)(vp + 3 * 272) = (u16)(w.y >> 16);
            *(LAS u16*)(vp + 4 * 272) = (u16)(w.z & 0xffff); *(LAS u16*)(vp + 5 * 272) = (u16)(w.z >> 16);
            *(LAS u16*)(vp + 6 * 272) = (u16)(w.w & 0xffff); *(LAS u16*)(vp + 7 * 272) = (u16)(w.w >> 16);
            *(LAS u32x4*)(Rh + sI * 272 + pc * 16) = *(const u32x4*)(rtb + (size_t)(hoff + sI) * 128 + pc * 8); }
        __syncthreads();
#pragma unroll
        for (int ks = 0; ks < 4; ++ks) { const bf16x8 pf = *(const LAS bf16x8*)(Ps + c * 272 + (32 * ks + 8 * fq) * 2);
#pragma unroll
            for (int vt = 0; vt < 8; ++vt) { const bf16x8 vf = *(const LAS bf16x8*)(Vh + (16 * vt + fr) * 272 + (32 * ks + 8 * fq) * 2); y[hf][vt] = mfma16(vf, pf, y[hf][vt]); } __builtin_amdgcn_sched_barrier(0); }
#pragma unroll
        for (int ks = 0; ks < 4; ++ks) {
#pragma unroll
            for (int vt = 0; vt < 8; ++vt) { const bf16x8 rf = *(const LAS bf16x8*)(Rh + (16 * vt + fr) * 272 + (32 * ks + 8 * fq) * 2); y[hf][vt] = mfma16(rf, qx[ks], y[hf][vt]); } __builtin_amdgcn_sched_barrier(0); }
#pragma unroll
        for (int vt = 0; vt < 8; ++vt) asm volatile("" : "+v"(y[hf][vt]));
    }
    float sum = 0.f;
#pragma unroll
    for (int hf = 0; hf < 2; ++hf)
#pragma unroll
        for (int vt = 0; vt < 8; ++vt) sum += (y[hf][vt][0] + y[hf][vt][1]) + (y[hf][vt][2] + y[hf][vt][3]);
    sum += __shfl_xor(sum, 16); sum += __shfl_xor(sum, 32);
    const float mu = sum * (1.0f / 256.0f);
    float var = 0.f;
#pragma unroll
    for (int hf = 0; hf < 2; ++hf)
#pragma unroll
        for (int vt = 0; vt < 8; ++vt) { const f32x4 d = y[hf][vt] - mu; var += (d[0] * d[0] + d[1] * d[1]) + (d[2] * d[2] + d[3] * d[3]); }
    var += __shfl_xor(var, 16); var += __shfl_xor(var, 32);
    const float rstd = rsqrtf(var * (1.0f / 256.0f) + EPSF);
    const u16* zp = zbase + (size_t)c * NE;
    u16* yp = y0 + (row0 + c) * DM + h * 256;
#pragma unroll
    for (int hf = 0; hf < 2; ++hf)
#pragma unroll
        for (int vt = 0; vt < 8; ++vt) { const int v = 128 * hf + 16 * vt + 4 * fq;
            const f32x4 gv = *(const f32x4*)(gn + h * 256 + v); const u32x2 zw = *(const u32x2*)(zp + v);
            const float z0 = bflo(zw.x), z1 = bfhi(zw.x), z2 = bflo(zw.y), z3 = bfhi(zw.y);
            const f32x4 t = (y[hf][vt] - mu) * rstd * gv;
            u32x2 w; w.x = cvt_pk_bf16(t[0] * silu_f(z0), t[1] * silu_f(z1)); w.y = cvt_pk_bf16(t[2] * silu_f(z2), t[3] * silu_f(z3));
            *(u32x2*)(yp + v) = w; }
}

__global__ void __launch_bounds__(512) hybrid_fwd(Params P) {
    cg::grid_group grid = cg::this_grid();
    extern __shared__ __attribute__((aligned(16))) unsigned char smem[];
    LAS unsigned char* lds = (LAS unsigned char*)smem;
    const int bid = blockIdx.x, G = gridDim.x;
    const float* x = P.in[0]; const float* p = P.in[1]; const float* pre_g = P.in[2]; const float* w_in_e = P.in[3];
    const float* q_g = P.in[4]; const float* k_g = P.in[5]; const float* gn_g = P.in[6]; const float* w_out_e = P.in[7];
    const float* w_in_o = P.in[8]; const float* conv_w = P.in[9]; const float* w_out_o = P.in[10]; const float* ple_g = P.in[11];
    const float* w_gate = P.in[12]; const float* w_pp = P.in[13];
    float* out = P.out;

    for (int ph = P.ph_lo; ph < P.ph_hi; ++ph) {
        int tid = threadIdx.x; asm volatile("" : "+v"(tid));
        const int wid = __builtin_amdgcn_readfirstlane(tid >> 6), lane = tid & 63;
        const size_t gtid = (size_t)bid * 512 + tid, gthreads = (size_t)G * 512;
        unsigned char* ws = P.ws; asm volatile("" : "+s"(ws));
        u16* WT_IN = (u16*)(ws + WS_WT_IN); u16* WT_O0 = (u16*)(ws + WS_WT_O0); u16* WT_O1 = (u16*)(ws + WS_WT_O1);
        u16* WT_G0 = (u16*)(ws + WS_WT_G0); u16* WT_G1 = (u16*)(ws + WS_WT_G1); u16* WT_P0 = (u16*)(ws + WS_WT_P0); u16* WT_P1 = (u16*)(ws + WS_WT_P1);
        u16* PROJ = (u16*)(ws + WS_PROJ); u16* XA = (u16*)(ws + WS_XA); u16* XB = (u16*)(ws + WS_XB); u16* PBF = (u16*)(ws + WS_PBF);
        float* RS = (float*)(ws + WS_RS); float* LSE = (float*)(ws + WS_LSE);
        u16* OG = (u16*)out;
        float* ST = (float*)XA;
        u16* RT = XB;
        if (EN_P0 && ph == 0) {
            constexpr int I_IN = 32 * 112, I_SQ = 32 * 32, I_P = 4 * 32;
            constexpr int NIT = I_IN + 4 * I_SQ + 2 * I_P;
            for (int it = bid; it < NIT; it += G) { int r = it; LAS float* scr = (LAS float*)lds;
                if (r < I_IN) { transpose_item(w_in_e, 2048, NE, WT_IN, scr, r, tid); continue; } r -= I_IN;
                if (r < I_SQ) { transpose_item(w_out_e, 2048, 2048, WT_O0, scr, r, tid); continue; } r -= I_SQ;
                if (r < I_SQ) { transpose_item(w_out_o, 2048, 2048, WT_O1, scr, r, tid); continue; } r -= I_SQ;
                if (r < I_SQ) { transpose_item(w_gate, 2048, 2048, WT_G0, scr, r, tid); continue; } r -= I_SQ;
                if (r < I_SQ) { transpose_item(w_gate + (size_t)2048 * 2048, 2048, 2048, WT_G1, scr, r, tid); continue; } r -= I_SQ;
                if (r < I_P) { transpose_item(w_pp, 256, 2048, WT_P0, scr, r, tid); continue; } r -= I_P;
                transpose_item(w_pp + (size_t)256 * 2048, 256, 2048, WT_P1, scr, r, tid); }
            for (int row = bid * 8 + wid; row < MROWS; row += G * 8) { const float* xr = x + (size_t)row * DM; u16* orow = XA + (size_t)row * DM; float ss = 0.f;
#pragma unroll
                for (int j = 0; j < 8; ++j) { const int col = 4 * lane + 256 * j; const f32x4 v = *(const f32x4*)(xr + col); const f32x4 gv = *(const f32x4*)(pre_g + col);
                    ss += (v[0] * v[0] + v[1] * v[1]) + (v[2] * v[2] + v[3] * v[3]); const f32x4 t = v * gv;
                    u32x2 w; w.x = cvt_pk_bf16(t[0], t[1]); w.y = cvt_pk_bf16(t[2], t[3]); *(u32x2*)(orow + col) = w; }
#pragma unroll
                for (int o = 1; o < 64; o <<= 1) ss += __shfl_xor(ss, o);
                if (lane == 0) RS[row] = ss; }
            for (size_t i = gtid; i < (size_t)2 * MROWS * 256 / 8; i += gthreads) { const f32x4 a = *(const f32x4*)(p + i * 8), b2 = *(const f32x4*)(p + i * 8 + 4);
                u32x4 w; w.x = cvt_pk_bf16(a[0], a[1]); w.y = cvt_pk_bf16(a[2], a[3]); w.z = cvt_pk_bf16(b2[0], b2[1]); w.w = cvt_pk_bf16(b2[2], b2[3]); *(u32x4*)(PBF + i * 8) = w; }
            for (size_t i = gtid; i < (size_t)3 * MROWS; i += gthreads) RS[MROWS + i] = 0.f;
        }
        if (EN_P2 && ph == 2) {
            for (int it = bid; it < 512 + 3072; it += G) {
                if (it < 512) ret_contrib_item(lds, PROJ, ST, it, tid, wid, lane);
                else attn_item(lds, PROJ, OG, LSE, q_g, k_g, it - 512, tid, wid, lane); }
        }
        if (EN_P3 && ph == 3) {
            for (size_t i = gtid; i < (size_t)16 * 8192; i += gthreads) { const int bh = (int)(i >> 13), e4 = (int)(i & 8191); const float gc = __expf(ret_log_g(bh & 3) * 128.0f);
                const float* sp = ST + (size_t)bh * 32 * 32768 + (size_t)e4 * 4; u16* rp = RT + (size_t)bh * 32 * 32768 + (size_t)e4 * 4;
                f32x4 R = {0.f, 0.f, 0.f, 0.f};
#pragma unroll 8
                for (int n = 0; n < 32; ++n) { const f32x4 sv = *(const f32x4*)(sp + (size_t)n * 32768);
                    u32x2 w; w.x = cvt_pk_bf16(R[0], R[1]); w.y = cvt_pk_bf16(R[2], R[3]); *(u32x2*)(rp + (size_t)n * 32768) = w;
                    R = R * gc + sv; } }
            for (int it = bid; it < 32 * 128; it += G) transpose_item(w_in_o, 2048, NO, WT_IN, (LAS float*)lds, it, tid);
        }
        if (EN_P4 && ph == 4) {
            for (int it = bid; it < 512; it += G) ret_out_item(lds, PROJ, RT, gn_g, XA, it, tid, wid, lane);
            for (size_t i = gtid; i < (size_t)MROWS * 128; i += gthreads) { const size_t row = i >> 7; const int c8 = (int)(i & 127), h = c8 >> 4, col = c8 * 8;
                const float l0 = LSE[row * 8 + h], l1 = LSE[((size_t)MROWS + row) * 8 + h], l2 = LSE[((size_t)2 * MROWS + row) * 8 + h];
                const float m = fmaxf(l0, fmaxf(l1, l2)); float e0 = __expf(l0 - m), e1 = __expf(l1 - m), e2 = __expf(l2 - m); const float inv = 1.0f / (e0 + e1 + e2);
                e0 *= inv; e1 *= inv; e2 *= inv;
                float a0[8], a1[8], a2[8], zf[8], r[8];
                unpack8(*(const u32x4*)(OG + row * 1024 + col), a0); unpack8(*(const u32x4*)(OG + ((size_t)MROWS + row) * 1024 + col), a1);
                unpack8(*(const u32x4*)(OG + ((size_t)2 * MROWS + row) * 1024 + col), a2); unpack8(*(const u32x4*)(PROJ + row * NE + 6144 + col), zf);
#pragma unroll
                for (int j = 0; j < 8; ++j) r[j] = (e0 * a0[j] + e1 * a1[j] + e2 * a2[j]) * silu_f(zf[j]);
                *(u32x4*)(XA + row * DM + 1024 + col) = pack8(r); }
        }
        if (EN_P8 && ph == 8) {
            for (size_t i = gtid; i < (size_t)MROWS * 256; i += gthreads) { const size_t row = i >> 8; const int col = (int)(i & 255) * 8; const int t = (int)(row & (SEQ - 1));
                const u16* pr = PROJ + row * NO + col;
                float bv[8], c0[8], u0[8], zf[8], c1[8], u1[8], c2[8], u2[8], r[8];
                unpack8(*(const u32x4*)(pr), bv); unpack8(*(const u32x4*)(pr + 2048), c0); unpack8(*(const u32x4*)(pr + 4096), u0); unpack8(*(const u32x4*)(pr + 6144), zf);
                if (t >= 1) { unpack8(*(const u32x4*)(pr - NO + 2048), c1); unpack8(*(const u32x4*)(pr - NO + 4096), u1); } else {
#pragma unroll
                    for (int j = 0; j < 8; ++j) { c1[j] = 0.f; u1[j] = 0.f; } }
                if (t >= 2) { unpack8(*(const u32x4*)(pr - 2 * NO + 2048), c2); unpack8(*(const u32x4*)(pr - 2 * NO + 4096), u2); } else {
#pragma unroll
                    for (int j = 0; j < 8; ++j) { c2[j] = 0.f; u2[j] = 0.f; } }
#pragma unroll
                for (int j = 0; j < 8; ++j) { const float cv = conv_w[col + j] * (c2[j] * u2[j]) + conv_w[2048 + col + j] * (c1[j] * u1[j]) + conv_w[4096 + col + j] * (c0[j] * u0[j]);
                    r[j] = bv[j] * cv * silu_f(zf[j]); }
                *(u32x4*)(XA + row * DM + col) = pack8(r); }
        }
        if (EN_GR && (ph == 5 || ph == 9)) {
            const bool l1 = (ph == 9);
            pg8::Gemm g{XA, l1 ? WT_O1 : WT_O0, MROWS, DM, 2048}; pg8::StaticOrder so; so.init(MROWS, DM, G, bid);
            pg8::EpiResid e{l1 ? (const float*)out : x, out, XB, ple_g + (l1 ? 2048 : 0), RS + (l1 ? 3 : 1) * MROWS};
            pg8::gemm_phase<pg8::EpiResid, pg8::StaticOrder, false>(lds, g, so, e, nullptr);
        }
        if (EN_GS && (ph == 1 || ph == 7 || ph == 5 || ph == 9)) {
            pg8::Gemm g; pg8::EpiScaleBf16 e; int N;
            if (ph == 1) { g = pg8::Gemm{XA, WT_IN, MROWS, NE, 2048}; e = pg8::EpiScaleBf16{PROJ, NE, RS}; N = NE; }
            else if (ph == 7) { g = pg8::Gemm{XA, WT_IN, MROWS, NO, 2048}; e = pg8::EpiScaleBf16{PROJ, NO, RS + 2 * MROWS}; N = NO; }
            else { const bool l1 = (ph == 9); g = pg8::Gemm{PBF + (l1 ? (size_t)MROWS * 256 : 0), l1 ? WT_P1 : WT_P0, MROWS, DM, 256}; e = pg8::EpiScaleBf16{PROJ, DM, nullptr}; N = DM; }
            pg8::StaticOrder so; so.init(MROWS, N, G, bid);
            pg8::gemm_phase<pg8::EpiScaleBf16, pg8::StaticOrder, false>(lds, g, so, e, nullptr);
        }
        if (EN_GG && (ph == 6 || ph == 10)) {
            const bool l1 = (ph == 10);
            pg8::Gemm g{XB, l1 ? WT_G1 : WT_G0, MROWS, DM, 2048}; pg8::StaticOrder so; so.init(MROWS, DM, G, bid);
            pg8::EpiGate e{RS + (l1 ? 3 : 1) * MROWS, PROJ, out, l1 ? (u16*)nullptr : XA, pre_g + 2048, RS + 2 * MROWS};
            pg8::gemm_phase<pg8::EpiGate, pg8::StaticOrder, false>(lds, g, so, e, nullptr);
        }
        if (ph + 1 < P.ph_hi) grid.sync();
    }
}

extern "C" void kernel_launch(void* const* d_in, const int* in_sizes, int n_in, void* d_out, int out_size, void* d_ws, size_t ws_size, hipStream_t stream) {
    static int grid = 0;
    if (grid == 0) {
        if (n_in != 14 || out_size != MROWS * DM || ws_size < WS_END) { fprintf(stderr, "kernel_launch: unexpected shapes (n_in %d out %d ws %zu need %zu)\n", n_in, out_size, ws_size, (size_t)WS_END); grid = -1; return; }
        int dev = 0, cus = 0, per_cu = 0;
        hipGetDevice(&dev); hipDeviceGetAttribute(&cus, hipDeviceAttributeMultiprocessorCount, dev);
        if (hipFuncSetAttribute((const void*)hybrid_fwd, hipFuncAttributeMaxDynamicSharedMemorySize, LDS_BYTES) != hipSuccess) { fprintf(stderr, "kernel_launch: hipFuncSetAttribute failed\n"); grid = -1; return; }
        if (hipOccupancyMaxActiveBlocksPerMultiprocessor(&per_cu, (const void*)hybrid_fwd, 512, LDS_BYTES) != hipSuccess || per_cu < 1) { fprintf(stderr, "kernel_launch: occupancy query says %d\n", per_cu); (void)hipGetLastError(); per_cu = 1; }
        grid = cus * per_cu;
    }
    if (grid < 0) return;
    Params P{};
    for (int i = 0; i < 14; ++i) P.in[i] = (const float*)d_in[i];
    P.out = (float*)d_out; P.ws = (unsigned char*)d_ws; P.ph_lo = 0; P.ph_hi = 11;
    void* args[] = {&P};
    hipError_t e = hipLaunchCooperativeKernel((const void*)hybrid_fwd, dim3(grid), dim3(512), args, LDS_BYTES, stream);
    if (e != hipSuccess) fprintf(stderr, "cooperative launch failed: %s (grid %d)\n", hipGetErrorString(e), grid);
}
```

```cpp
#include <hip/hip_runtime.h>
#include <hip/hip_cooperative_groups.h>
#include <cstdio>
namespace cg = cooperative_groups;
namespace pg8 {
#define PG8_LAS __attribute__((address_space(3)))
typedef unsigned short bf16_t;
typedef short bf16x8 __attribute__((ext_vector_type(8)));
typedef float f32x4 __attribute__((ext_vector_type(4)));
typedef unsigned u32x4 __attribute__((ext_vector_type(4)));
constexpr int BM = 256, BK = 64, HALF = 128, HTB = HALF * BK * 2  , STAGE_BYTES = 8 * HTB, NXCD = 8, WGM = 4;

__host__ __device__ __forceinline__ int lds_byte(int r, int c) { const int st = (r >> 4) * 2 + (c >> 5), rr = r & 15, cc = c & 31, ob = rr * 64 + cc * 2; return st * 1024 + (ob ^ (((ob >> 9) & 1) << 5)); }
__host__ __device__ __forceinline__ void stage_rc(int b, int& R, int& C) { const int st = b / 1024, sb = b % 1024, swz = sb ^ (((sb >> 9) & 1) << 5); R = (st >> 1) * 16 + swz / 64; C = (st & 1) * 32 + (swz % 64) / 2; }
__host__ __device__ __forceinline__ int perm32(int rho) { const int n = rho >> 4, i = rho & 15; return 8 * (i >> 2) + 4 * n + (i & 3); }

struct Unit { int pm, pn; };
struct Gemm { const bf16_t* A; const bf16_t* Bt; int M, N, K, ldA, ldB; };

struct StaticOrder {
    int nM, nN, nwg, G, c;
    __host__ __device__ void init(int M, int N, int G_, int c_) { nM = M / BM; nN = N / BM; nwg = nM * nN; G = G_; c = c_; }
    __host__ __device__ bool next(int i, Unit& u) const {
        const long L = (long)i * G + c; if (L >= nwg) return false;
        int wgid = (int)L; { const int q = nwg / NXCD, r = nwg % NXCD, xcd = wgid % NXCD, off = wgid / NXCD; wgid = (xcd < r ? xcd * (q + 1) : r * (q + 1) + (xcd - r) * q) + off; }
        const int nig = WGM * nN, gid = wgid / nig, fm = gid * WGM, gsz = (nM - fm) < WGM ? (nM - fm) : WGM;
        u.pm = fm + ((wgid % nig) % gsz); u.pn = (wgid % nig) / gsz; return true;
    }
    __device__ __forceinline__ void a_ready(const Unit&) const {}
    __device__ __forceinline__ void done(const Unit&) const {}
};
__device__ __forceinline__ unsigned cvt_pk_bf16(float lo, float hi) { unsigned r; asm volatile("v_cvt_pk_bf16_f32 %0, %1, %2" : "=v"(r) : "v"(lo), "v"(hi)); return r; }
typedef float f32x2 __attribute__((ext_vector_type(2)));
typedef unsigned u32x2 __attribute__((ext_vector_type(2)));
__device__ __forceinline__ float sq4(const f32x4 v) { return (v[0] * v[0] + v[1] * v[1]) + (v[2] * v[2] + v[3] * v[3]); }
template <int CTRL> __device__ __forceinline__ float dpp_ror(float x) { return __int_as_float(__builtin_amdgcn_update_dpp(0, __float_as_int(x), CTRL, 0xf, 0xf, false)); }
struct EpiScaleBf16 {
    static constexpr bool PERM = true, AFTER_DRAIN = false;
    bf16_t* O; int ldc; const float* rs; const float* cw; float* vside; float* wside; float* kss;
    __device__ __forceinline__ void prefetch(const Unit& u, int wr, int fr, float (&rsv)[4]) const {
        const int row0 = u.pm * BM + wr * 64 + fr;
#pragma unroll
        for (int m = 0; m < 4; ++m) rsv[m] = rs ? rs[row0 + m * 16] : 2048.0f;
    }
    __device__ __forceinline__ void operator()(const f32x4 (&acc)[2][2][4][2], const Unit& u, int wr, int wc, int fr, int fq, const float (&rsv)[4]) const {
        if (!cw) {
            const int row0 = u.pm * BM + wr * 64 + fr, col0 = u.pn * BM + wc * 64 + 8 * fq;
            float rs2[4];
#pragma unroll
            for (int m = 0; m < 4; ++m) rs2[m] = rs ? rs[row0 + HALF + m * 16] : 2048.0f;
#pragma unroll
            for (int ai = 0; ai < 2; ++ai)
#pragma unroll
                for (int m = 0; m < 4; ++m) { const int row = row0 + ai * HALF + m * 16;
                    const float sc = rs ? rsqrtf((ai ? rs2[m] : rsv[m]) * (1.0f / 2048.0f) + 1e-6f) : 1.0f;
                    bf16_t* rowp = O + (size_t)row * ldc + col0;
#pragma unroll
                    for (int bj = 0; bj < 2; ++bj) { const f32x4 v0 = acc[ai][bj][m][0] * sc, v1 = acc[ai][bj][m][1] * sc;
                        u32x4 w; w.x = cvt_pk_bf16(v0[0], v0[1]); w.y = cvt_pk_bf16(v0[2], v0[3]); w.z = cvt_pk_bf16(v1[0], v1[1]); w.w = cvt_pk_bf16(v1[2], v1[3]);
                        *(u32x4*)(rowp + bj * 32) = w;
                        if (kss && (u.pn >> 2) == 3) {
                            float ss = sq4(v0) + sq4(v1); ss += __shfl_xor(ss, 16); ss += __shfl_xor(ss, 32);
                            if (fq == 0) atomicAdd(kss + (size_t)row * 8 + 2 * (u.pn - 12) + (wc >> 1), ss); } } }
        } else {
            const int row0 = u.pm * BM + wr * 64 + fr, ch0 = u.pn * 64 + wc * 16 + 4 * fq;
            const f32x4 c0 = *(const f32x4*)(cw + ch0), c1 = *(const f32x4*)(cw + 2048 + ch0), c2 = *(const f32x4*)(cw + 4096 + ch0);
            float rs2[4];
#pragma unroll
            for (int m = 0; m < 4; ++m) rs2[m] = rs[row0 + HALF + m * 16];
#pragma unroll
            for (int ai = 0; ai < 2; ++ai) { f32x4 vprev = {0.f, 0.f, 0.f, 0.f};
                const size_t b64 = (size_t)((u.pm * BM + ai * HALF + wr * 64) >> 6);
#pragma unroll
                for (int m = 0; m < 4; ++m) { const int row = row0 + ai * HALF + m * 16;
                    const float sc = rsqrtf((ai ? rs2[m] : rsv[m]) * (1.0f / 2048.0f) + 1e-6f);
                    const f32x4 Bv = acc[ai][0][m][0] * sc, zv = acc[ai][0][m][1] * sc, Cv = acc[ai][1][m][0] * sc, uv = acc[ai][1][m][1] * sc;
                    const f32x4 v = Cv * uv; f32x4 wv, v1, v2;
#pragma unroll
                    for (int j = 0; j < 4; ++j) { wv[j] = Bv[j] * zv[j] * __builtin_amdgcn_rcpf(1.0f + __expf(-zv[j]));
                        const float a1 = dpp_ror<0x121>(v[j]), p1 = dpp_ror<0x121>(vprev[j]), a2 = dpp_ror<0x122>(v[j]), p2 = dpp_ror<0x122>(vprev[j]);
                        v1[j] = fr >= 1 ? a1 : p1; v2[j] = fr >= 2 ? a2 : p2; }
                    const f32x4 y = wv * (c2 * v + c1 * v1 + c0 * v2);
                    if (m == 0 && fr < 2) { *(f32x4*)(vside + (b64 * 4 + fr) * 2048 + ch0) = v; *(f32x4*)(wside + (b64 * 2 + fr) * 2048 + ch0) = wv; }
                    else { u32x2 w; w.x = cvt_pk_bf16(y[0], y[1]); w.y = cvt_pk_bf16(y[2], y[3]); *(u32x2*)(O + (size_t)row * 2048 + ch0) = w; }
                    if (m == 3 && fr >= 14) *(f32x4*)(vside + (b64 * 4 + 2 + (fr - 14)) * 2048 + ch0) = v;
                    vprev = v; } }
        }
    }
};
__device__ __forceinline__ void unpk8(const u32x4 w, f32x4& lo, f32x4& hi) {
    lo[0] = __uint_as_float(w.x << 16); lo[1] = __uint_as_float(w.x & 0xffff0000u); lo[2] = __uint_as_float(w.y << 16); lo[3] = __uint_as_float(w.y & 0xffff0000u);
    hi[0] = __uint_as_float(w.z << 16); hi[1] = __uint_as_float(w.z & 0xffff0000u); hi[2] = __uint_as_float(w.w << 16); hi[3] = __uint_as_float(w.w & 0xffff0000u); }
__device__ __forceinline__ u32x4 pk8(const f32x4 lo, const f32x4 hi) { u32x4 w; w.x = cvt_pk_bf16(lo[0], lo[1]); w.y = cvt_pk_bf16(lo[2], lo[3]); w.z = cvt_pk_bf16(hi[0], hi[1]); w.w = cvt_pk_bf16(hi[2], hi[3]); return w; }
template <bool F32IN> struct EpiResid {
    static constexpr bool PERM = true, AFTER_DRAIN = false;
    const float* xin32; const bf16_t* xin16; bf16_t* xo; float* rs;
    __device__ __forceinline__ void prefetch(const Unit&, int, int, float (&)[4]) const {}
    typedef f32x4 XBuf[2][2][F32IN ? 2 : 1];
    __device__ __forceinline__ void load2(int c, size_t off0, XBuf& x) const {
#pragma unroll
        for (int g = 0; g < 2; ++g) { const size_t off = off0 + (size_t)((c >> 1) * HALF + (2 * (c & 1) + g) * 16) * 2048;
#pragma unroll
            for (int bj = 0; bj < 2; ++bj) {
                if constexpr (F32IN) { x[g][bj][0] = *(const f32x4*)(xin32 + off + bj * 32); x[g][bj][1] = *(const f32x4*)(xin32 + off + bj * 32 + 4); }
                else x[g][bj][0] = *(const f32x4*)(xin16 + off + bj * 32);     } }
    }
    __device__ __forceinline__ void proc2(const f32x4 (&acc)[2][2][4][2], int c, int row0, size_t off0, int fq, const XBuf& x) const {
        const int ai = c >> 1;
#pragma unroll
        for (int g = 0; g < 2; ++g) { const int m = 2 * (c & 1) + g; const int row = row0 + ai * HALF + m * 16; const size_t off = off0 + (size_t)(ai * HALF + m * 16) * 2048; float s = 0.f;
#pragma unroll
            for (int bj = 0; bj < 2; ++bj) { f32x4 x0, x1;
                if constexpr (F32IN) { x0 = x[g][bj][0]; x1 = x[g][bj][1]; }
                else { const f32x4 r = x[g][bj][0]; u32x4 w; w.x = __float_as_uint(r[0]); w.y = __float_as_uint(r[1]); w.z = __float_as_uint(r[2]); w.w = __float_as_uint(r[3]); unpk8(w, x0, x1); }
                const f32x4 v0 = x0 + acc[ai][bj][m][0], v1 = x1 + acc[ai][bj][m][1];
                s += sq4(v0) + sq4(v1); *(u32x4*)(xo + off + bj * 32) = pk8(v0, v1); }
            s += __shfl_xor(s, 16); s += __shfl_xor(s, 32);
            if (fq == 0) atomicAdd(rs + row, s); }
        asm volatile("" ::: "memory");
    }
    __device__ __forceinline__ void operator()(const f32x4 (&acc)[2][2][4][2], const Unit& u, int wr, int wc, int fr, int fq, const float (&)[4]) const {
        const int row0 = u.pm * BM + wr * 64 + fr, col0 = u.pn * BM + wc * 64 + 8 * fq; const size_t off0 = (size_t)row0 * 2048 + col0;
        XBuf xa, xb;
        load2(0, off0, xa);
        load2(1, off0, xb); proc2(acc, 0, row0, off0, fq, xa);
        load2(2, off0, xa); proc2(acc, 1, row0, off0, fq, xb);
        load2(3, off0, xb); proc2(acc, 2, row0, off0, fq, xa);
        proc2(acc, 3, row0, off0, fq, xb);
    }
};
struct EpiGate {
    static constexpr bool PERM = true, AFTER_DRAIN = false;
    const float* rs_in; const bf16_t* pp; const bf16_t* xin; bf16_t* xo16; float* xo32; float* rs_out;
    __device__ __forceinline__ void prefetch(const Unit& u, int wr, int fr, float (&rsv)[4]) const {
        const int row0 = u.pm * BM + wr * 64 + fr;
#pragma unroll
        for (int m = 0; m < 4; ++m) rsv[m] = rs_in[row0 + m * 16];
    }
    __device__ __forceinline__ void load2(int c, size_t off0, u32x4 (&xw)[2][2], u32x4 (&pw)[2][2]) const {
#pragma unroll
        for (int g = 0; g < 2; ++g) { const size_t off = off0 + (size_t)((c >> 1) * HALF + (2 * (c & 1) + g) * 16) * 2048;
#pragma unroll
            for (int bj = 0; bj < 2; ++bj) { xw[g][bj] = *(const u32x4*)(xin + off + bj * 32); pw[g][bj] = *(const u32x4*)(pp + off + bj * 32); } }
    }
    __device__ __forceinline__ void proc2(const f32x4 (&acc)[2][2][4][2], int c, int row0, size_t off0, int fq, const float (&rsx)[4], const u32x4 (&xw)[2][2], const u32x4 (&pw)[2][2]) const {
        const int ai = c >> 1;
#pragma unroll
        for (int g = 0; g < 2; ++g) { const int m = 2 * (c & 1) + g; const int row = row0 + ai * HALF + m * 16; const size_t off = off0 + (size_t)(ai * HALF + m * 16) * 2048; float s = 0.f;
            const float sc = rsqrtf(rsx[m] * (1.0f / 2048.0f) + 1e-6f);
#pragma unroll
            for (int bj = 0; bj < 2; ++bj) { f32x4 x0, x1, p0, p1; unpk8(xw[g][bj], x0, x1); unpk8(pw[g][bj], p0, p1);
                const f32x4 a0 = acc[ai][bj][m][0] * sc, a1 = acc[ai][bj][m][1] * sc; f32x4 v0, v1;
#pragma unroll
                for (int j = 0; j < 4; ++j) { v0[j] = x0[j] + p0[j] * __builtin_amdgcn_rcpf(1.0f + __expf(-a0[j])); v1[j] = x1[j] + p1[j] * __builtin_amdgcn_rcpf(1.0f + __expf(-a1[j])); }
                if (xo32) { *(f32x4*)(xo32 + off + bj * 32) = v0; *(f32x4*)(xo32 + off + bj * 32 + 4) = v1; }
                else { s += sq4(v0) + sq4(v1); *(u32x4*)(xo16 + off + bj * 32) = pk8(v0, v1); } }
            if (!xo32) { s += __shfl_xor(s, 16); s += __shfl_xor(s, 32); if (fq == 0) atomicAdd(rs_out + row, s); } }
        asm volatile("" ::: "memory");
    }
    __device__ __forceinline__ void operator()(const f32x4 (&acc)[2][2][4][2], const Unit& u, int wr, int wc, int fr, int fq, const float (&rsv)[4]) const {
        const int row0 = u.pm * BM + wr * 64 + fr, col0 = u.pn * BM + wc * 64 + 8 * fq; const size_t off0 = (size_t)row0 * 2048 + col0;
        float rs2[4];
#pragma unroll
        for (int m = 0; m < 4; ++m) rs2[m] = rs_in[row0 + HALF + m * 16];
        u32x4 xa[2][2], pa[2][2], xb[2][2], pb[2][2];
        load2(0, off0, xa, pa);
        load2(1, off0, xb, pb); proc2(acc, 0, row0, off0, fq, rsv, xa, pa);
        load2(2, off0, xa, pa); proc2(acc, 1, row0, off0, fq, rsv, xb, pb);
        load2(3, off0, xb, pb); proc2(acc, 2, row0, off0, fq, rs2, xa, pa);
        proc2(acc, 3, row0, off0, fq, rs2, xb, pb);
    }
};
template <class Epi, class Sched, bool STAMP = false>
__device__ __forceinline__ void gemm_phase(PG8_LAS unsigned char* lds, const Gemm g, const Sched& S, const Epi& E, unsigned long long* stamps) {
    int tid_ = threadIdx.x; asm volatile("" : "+v"(tid_));
    const int tid = tid_, wid = __builtin_amdgcn_readfirstlane(tid >> 6), lane = tid & 63, wr = wid >> 2, wc = wid & 3, fr = lane & 15, fq = lane >> 4;
    const int K = g.K, nt = K / BK;
    int ts_lo = 0, ts_hi = 0, nts = 0; const unsigned long long rt_entry = STAMP ? (unsigned long long)wall_clock64() : 0ull;
#define PG8_STAMP() do { if (STAMP && wid == 0 && nts < 64) { const unsigned long long _c = (unsigned long long)clock64(); \
        ts_lo = (lane == nts) ? (int)(unsigned)_c : ts_lo; ts_hi = (lane == nts) ? (int)(unsigned)(_c >> 32) : ts_hi; ++nts; } } while (0)
    PG8_STAMP();
    unsigned voffA[2], voffB[2];
#pragma unroll
    for (int i = 0; i < 2; ++i) { int R, C; stage_rc(tid * 16 + i * 8192, R, C); const int Rb = Epi::PERM ? ((R & ~31) + perm32(R & 31)) : R;
        voffA[i] = (unsigned)(R * g.ldA + C) * 2u; voffB[i] = (unsigned)(Rb * g.ldB + C) * 2u; }
    const size_t kstep = (size_t)(BK * 2);
    const size_t hstepA = (size_t)HALF * g.ldA * 2, hstepB = (size_t)HALF * g.ldB * 2;
    const size_t tstepA = 2 * hstepA, tstepB = 2 * hstepB;
    const unsigned ldsw = (unsigned)wid * 1024u;
    const int aoff = lds_byte(wr * 64 + fr, fq * 8), boff = lds_byte(wc * 32 + fr, fq * 8);
#define PG8_SA(b, h) (((b) * 2 + (h)) * HTB)
#define PG8_SB(b, h) ((4 + (b) * 2 + (h)) * HTB)
#define PG8_STAGE(bufoff, gbase, voff) do { _Pragma("unroll") for (int _i = 0; _i < 2; ++_i) \
        __builtin_amdgcn_global_load_lds((const unsigned*)((const char*)(gbase) + (voff)[_i]), (PG8_LAS unsigned*)(lds + (bufoff) + ldsw + _i * 8192), 16, 0, 0); } while (0)
#define PG8_LDA(dst, b, h) do { _Pragma("unroll") for (int m = 0; m < 4; ++m) _Pragma("unroll") for (int k = 0; k < 2; ++k) dst[m][k] = *(const PG8_LAS bf16x8*)(lds + PG8_SA(b, h) + aoff + m * 2048 + k * 1024); } while (0)
#define PG8_LDB(dst, b, h) do { _Pragma("unroll") for (int n = 0; n < 2; ++n) _Pragma("unroll") for (int k = 0; k < 2; ++k) dst[n][k] = *(const PG8_LAS bf16x8*)(lds + PG8_SB(b, h) + boff + n * 2048 + k * 1024); } while (0)
#define PG8_MMA(ai, bj, At, Bt) do { __builtin_amdgcn_s_setprio(1); _Pragma("unroll") for (int m = 0; m < 4; ++m) _Pragma("unroll") for (int n = 0; n < 2; ++n) _Pragma("unroll") for (int k = 0; k < 2; ++k) \
        acc[ai][bj][m][n] = __builtin_amdgcn_mfma_f32_16x16x32_bf16(Bt[n][k], At[m][k], acc[ai][bj][m][n], 0, 0, 0); __builtin_amdgcn_s_setprio(0); } while (0)
#define PG8_WAIT_V(n) asm volatile("s_waitcnt vmcnt(" #n ")" ::: "memory")
#define PG8_WAIT_L(n) asm volatile("s_waitcnt lgkmcnt(" #n ")" ::: "memory")
#define PG8_BAR __builtin_amdgcn_s_barrier()
#define PG8_SCHED __builtin_amdgcn_sched_barrier(0)
    Unit cur, nxt; int ui = 0;
    if (!S.next(0, cur)) return;
    f32x4 acc[2][2][4][2];
    float rsv[4];
#pragma unroll
    for (int a = 0; a < 2; ++a)
#pragma unroll
        for (int b = 0; b < 2; ++b)
#pragma unroll
            for (int m = 0; m < 4; ++m)
#pragma unroll
                for (int n = 0; n < 2; ++n) acc[a][b][m][n] = (f32x4){0.f, 0.f, 0.f, 0.f};
    bf16x8 At[4][2], B0[2][2], B1[2][2];
    const char* cA = (const char*)g.A + (size_t)cur.pm * tstepA; const char* cB = (const char*)g.Bt + (size_t)cur.pn * tstepB;
    S.a_ready(cur);
    PG8_STAGE(PG8_SB(0, 0), cB, voffB); PG8_STAGE(PG8_SA(0, 0), cA, voffA); PG8_STAGE(PG8_SB(0, 1), cB + hstepB, voffB); PG8_STAGE(PG8_SA(0, 1), cA + hstepA, voffA);
    if (wr == 1) PG8_BAR;
    PG8_WAIT_V(4); PG8_BAR;
    PG8_STAGE(PG8_SB(1, 0), cB + kstep, voffB); PG8_STAGE(PG8_SA(1, 0), cA + kstep, voffA); PG8_STAGE(PG8_SB(1, 1), cB + hstepB + kstep, voffB);
    PG8_WAIT_V(6); PG8_BAR;
    PG8_STAMP();
    for (;;) {
        const bool has_next = S.next(ui + 1, nxt);
        const char* nA = has_next ? (const char*)g.A + (size_t)nxt.pm * tstepA : cA; const char* nB = has_next ? (const char*)g.Bt + (size_t)nxt.pn * tstepB : cB;
        for (int t = 0; t < nt; t += 2) {
            const bool last = (t == nt - 2);
            const char* a1 = cA + (size_t)(t + 1) * kstep;
            const char* a2 = last ? nA : cA + (size_t)(t + 2) * kstep; const char* b2 = last ? nB : cB + (size_t)(t + 2) * kstep;
            const char* a3 = a2 + kstep; const char* b3 = b2 + kstep;
            if (last && has_next) S.a_ready(nxt);
            if (last) E.prefetch(cur, wr, fr, rsv);
            PG8_LDB(B0, 0, 0); PG8_SCHED; PG8_LDA(At, 0, 0); PG8_STAGE(PG8_SA(1, 1), a1 + hstepA, voffA);
            PG8_WAIT_L(8); PG8_BAR; PG8_WAIT_L(0); PG8_MMA(0, 0, At, B0); PG8_BAR; PG8_SCHED;
            PG8_LDB(B1, 0, 1); PG8_STAGE(PG8_SB(0, 0), b2, voffB);
            PG8_BAR; PG8_WAIT_L(0); PG8_MMA(0, 1, At, B1); PG8_BAR;
            PG8_LDA(At, 0, 1); PG8_STAGE(PG8_SA(0, 0), a2, voffA);
            PG8_BAR; PG8_WAIT_L(0); PG8_MMA(1, 0, At, B0); PG8_BAR; PG8_SCHED;
            PG8_STAGE(PG8_SB(0, 1), b2 + hstepB, voffB);
            PG8_WAIT_V(6); PG8_BAR; PG8_MMA(1, 1, At, B1); PG8_BAR;
            PG8_LDB(B0, 1, 0); PG8_SCHED; PG8_LDA(At, 1, 0); PG8_STAGE(PG8_SA(0, 1), a2 + hstepA, voffA);
            PG8_WAIT_L(8); PG8_BAR; PG8_WAIT_L(0); PG8_MMA(0, 0, At, B0); PG8_BAR; PG8_SCHED;
            PG8_LDB(B1, 1, 1); PG8_STAGE(PG8_SB(1, 0), b3, voffB);
            PG8_BAR; PG8_WAIT_L(0); PG8_MMA(0, 1, At, B1); PG8_BAR;
            PG8_LDA(At, 1, 1); PG8_STAGE(PG8_SA(1, 0), a3, voffA);
            PG8_BAR; PG8_WAIT_L(0); PG8_MMA(1, 0, At, B0); PG8_BAR; PG8_SCHED;
            PG8_STAGE(PG8_SB(1, 1), b3 + hstepB, voffB);
            PG8_WAIT_V(6); PG8_BAR; PG8_MMA(1, 1, At, B1); PG8_BAR;
        }
        PG8_STAMP();
        if constexpr (!Epi::AFTER_DRAIN) { E(acc, cur, wr, wc, fr, fq, rsv); S.done(cur); }
        PG8_STAMP();
        if (!has_next) break;
#pragma unroll
        for (int a = 0; a < 2; ++a)
#pragma unroll
            for (int b = 0; b < 2; ++b)
#pragma unroll
                for (int m = 0; m < 4; ++m)
#pragma unroll
                    for (int n = 0; n < 2; ++n) acc[a][b][m][n] = (f32x4){0.f, 0.f, 0.f, 0.f};
        cur = nxt; cA = nA; cB = nB; ++ui;
    }
    PG8_WAIT_V(0);
    if (wr == 0) PG8_BAR;
    PG8_BAR;
    if constexpr (Epi::AFTER_DRAIN) { E.fused(acc, cur, wr, wc, fr, fq, lds, wid, lane); S.done(cur); }
    PG8_STAMP();
    if (STAMP && wid == 0) { stamps[lane] = lane < nts ? (((unsigned long long)(unsigned)ts_hi << 32) | (unsigned)ts_lo) : 0ull;
        if (lane == 62) stamps[62] = rt_entry; if (lane == 63) stamps[63] = (unsigned long long)wall_clock64(); }
#undef PG8_STAMP
#undef PG8_SA
#undef PG8_SB
#undef PG8_STAGE
#undef PG8_LDA
#undef PG8_LDB
#undef PG8_MMA
#undef PG8_WAIT_V
#undef PG8_WAIT_L
#undef PG8_BAR
#undef PG8_SCHED
}
}
#define LAS __attribute__((address_space(3)))
typedef unsigned short u16;
typedef unsigned int u32;
typedef pg8::bf16x8 bf16x8;
typedef pg8::f32x4 f32x4;
typedef pg8::u32x4 u32x4;
typedef pg8::u32x2 u32x2;
using pg8::cvt_pk_bf16;

constexpr int MROWS = 16384, DM = 2048, SEQ = 4096;
constexpr int NE = 7168, NO = 8192;
constexpr float EPSF = 1e-6f;
constexpr size_t SIDE_OFF = (size_t)64 * 1024 * 1024;
constexpr int LDS_BYTES = 139264 + 16;
#ifndef SCHED_BITS
#define SCHED_BITS 0xA976543210ull
#define SCHED_N 10
#endif

constexpr size_t WS_WT_IN  = 0;
constexpr size_t WS_WT_O0  = WS_WT_IN + (size_t)8192 * 2048 * 2;
constexpr size_t WS_WT_O1  = WS_WT_O0 + (size_t)2048 * 2048 * 2;
constexpr size_t WS_WT_G0  = WS_WT_O1 + (size_t)2048 * 2048 * 2;
constexpr size_t WS_WT_G1  = WS_WT_G0 + (size_t)2048 * 2048 * 2;
constexpr size_t WS_WT_P0  = WS_WT_G1 + (size_t)2048 * 2048 * 2;
constexpr size_t WS_WT_P1  = WS_WT_P0 + (size_t)2048 * 256 * 2;
constexpr size_t WS_PROJ   = WS_WT_P1 + (size_t)2048 * 256 * 2;
constexpr size_t WS_XA     = WS_PROJ + (size_t)16384 * 8192 * 2;
constexpr size_t WS_XB     = WS_XA + (size_t)16384 * 2048 * 2;
constexpr size_t WS_PBF    = WS_XB + (size_t)16384 * 2048 * 2;
constexpr size_t WS_RS     = WS_PBF + (size_t)2 * 16384 * 256 * 2;
constexpr size_t WS_LSE    = WS_RS + (size_t)4 * 16384 * 4;
constexpr size_t WS_BAR    = WS_LSE + (size_t)3 * 16384 * 8 * 4;
constexpr size_t WS_KSS    = WS_BAR + 16384;
constexpr size_t WS_END    = WS_KSS + (size_t)16384 * 8 * 4;

#ifndef EN_P0
#define EN_P0 1
#endif
#ifndef EN_P2
#define EN_P2 1
#endif
#ifndef EN_P3
#define EN_P3 1
#endif
#ifndef EN_P4
#define EN_P4 1
#endif
#ifndef EN_P8
#define EN_P8 1
#endif
#ifndef EN_GR
#define EN_GR 1
#endif
#ifndef EN_GS
#define EN_GS 1
#endif
#ifndef EN_GG
#define EN_GG 1
#endif
struct Params { const float* in[14]; float* out; unsigned char* ws; unsigned long long sched; int nsched, pad_; };

__device__ __forceinline__ float bflo(u32 w) { return __uint_as_float(w << 16); }
__device__ __forceinline__ float bfhi(u32 w) { return __uint_as_float(w & 0xffff0000u); }
__device__ __forceinline__ void unpack8(const u32x4 w, float (&f)[8]) { f[0] = bflo(w.x); f[1] = bfhi(w.x); f[2] = bflo(w.y); f[3] = bfhi(w.y); f[4] = bflo(w.z); f[5] = bfhi(w.z); f[6] = bflo(w.w); f[7] = bfhi(w.w); }
__device__ __forceinline__ u32x4 pack8(const float (&f)[8]) { u32x4 w; w.x = cvt_pk_bf16(f[0], f[1]); w.y = cvt_pk_bf16(f[2], f[3]); w.z = cvt_pk_bf16(f[4], f[5]); w.w = cvt_pk_bf16(f[6], f[7]); return w; }
template <int CTRL> __device__ __forceinline__ float dppf(float x) { return __int_as_float(__builtin_amdgcn_update_dpp(0, __float_as_int(x), CTRL, 0xf, 0xf, true)); }
__device__ __forceinline__ float row16_sum(float s) { s += dppf<0xB1>(s); s += dppf<0x4E>(s); s += dppf<0x124>(s); s += dppf<0x128>(s); return s; }
__device__ __forceinline__ float silu_f(float z) { return z * __builtin_amdgcn_rcpf(1.0f + __expf(-z)); }
__device__ __forceinline__ f32x4 mfma16(bf16x8 a, bf16x8 b, f32x4 c) { return __builtin_amdgcn_mfma_f32_16x16x32_bf16(a, b, c, 0, 0, 0); }

struct TJob { const float* W; u16* WT; const float* gk; int K, N, item, perm; };
__device__ __forceinline__ void t_load(const TJob& j, int tid, f32x4 (&v)[2], float (&gv)[2]) {
    const int nblk = j.N >> 6, kb = j.item / nblk, nb = j.item - kb * nblk, k0 = kb << 6, n0 = nb << 6, ty = tid >> 4, tx = tid & 15;
#pragma unroll
    for (int i = 0; i < 2; ++i) { const int kk = ty + 32 * i; v[i] = __builtin_nontemporal_load((const f32x4*)(j.W + (size_t)(k0 + kk) * j.N + n0 + 4 * tx)); gv[i] = j.gk ? j.gk[k0 + kk] : 1.0f; }
}
template <class Dec>
__device__ __forceinline__ void transpose_run(const Dec& dec, int nitems, LAS float* scr, int bid, int G, int tid) {
    asm volatile("" : "+v"(tid));
    if (bid >= nitems) return;
    f32x4 v[2]; float gv[2];
    { const TJob j0 = dec(bid); t_load(j0, tid, v, gv); }
    const int ty = tid >> 4, tx = tid & 15, n = tid >> 3, c = tid & 7;
    for (int it = bid; it < nitems; it += G) {
        const TJob j = dec(it);
#pragma unroll
        for (int i = 0; i < 2; ++i) { const int kk = ty + 32 * i; const f32x4 t = v[i] * gv[i];
            scr[kk * 65 + 4 * tx + 0] = t[0]; scr[kk * 65 + 4 * tx + 1] = t[1]; scr[kk * 65 + 4 * tx + 2] = t[2]; scr[kk * 65 + 4 * tx + 3] = t[3]; }
        __syncthreads();
        { const int nx = (it + G < nitems) ? it + G : it; const TJob jn = dec(nx); t_load(jn, tid, v, gv); }
        const int nblk = j.N >> 6, kb = j.item / nblk, nb = j.item - kb * nblk, k0 = kb << 6, n0 = nb << 6;
        const LAS float* s = scr + (8 * c) * 65 + n;
        u32x4 o; o.x = cvt_pk_bf16(s[0], s[65]); o.y = cvt_pk_bf16(s[2 * 65], s[3 * 65]); o.z = cvt_pk_bf16(s[4 * 65], s[5 * 65]); o.w = cvt_pk_bf16(s[6 * 65], s[7 * 65]);
        int orow = n0 + n;
        if (j.perm == 1) { const int part = orow >> 11, ch = orow & 2047; orow = 256 * (ch >> 6) + 128 * ((part == 1 || part == 2) ? 1 : 0) + 32 * ((ch >> 4) & 3) + 8 * ((ch >> 2) & 3) + (ch & 3) + ((part >= 2) ? 4 : 0); }
        else if (j.perm == 2) { const int c = orow & 255; orow = (orow & ~255) + 128 * ((c >> 5) & 1) + 32 * (c >> 6) + 8 * ((c >> 3) & 3) + (c & 7); }
        *(u32x4*)(j.WT + (size_t)orow * j.K + k0 + 8 * c) = o;
        __syncthreads();
    }
}

typedef unsigned short u16x4 __attribute__((ext_vector_type(4)));
__device__ __forceinline__ unsigned off_b(unsigned row, unsigned ch) { return 256u * row + 16u * (ch ^ (((row & 3u) << 2) | ((row >> 2) & 3u))); }
__device__ __forceinline__ u16x4 tr_issue(unsigned addr) { u16x4 r; asm volatile("ds_read_b64_tr_b16 %0, %1" : "=&v"(r) : "v"(addr) : "memory"); return r; }
__device__ __forceinline__ bf16x8 tr_join(const u16x4 a, const u16x4 b) { bf16x8 v; v[0] = (short)a[0]; v[1] = (short)a[1]; v[2] = (short)a[2]; v[3] = (short)a[3]; v[4] = (short)b[0]; v[5] = (short)b[1]; v[6] = (short)b[2]; v[7] = (short)b[3]; return v; }
__device__ __forceinline__ unsigned tr_addr(unsigned base, int lane, int ks, int c, int t) {
    const unsigned g = (unsigned)lane >> 4, q4 = ((unsigned)lane & 15u) >> 2, p4 = (unsigned)lane & 3u;
    return base + off_b(32u * ks + 8u * g + 4u * t + q4, 2u * c + (p4 >> 1)) + 8u * (p4 & 1u);
}

struct ARun { int g, b, h, dil, r, n0, len; };
__device__ __forceinline__ ARun attn_run(int rho) {
    ARun R; int bh;
    if (rho < 256) { R.g = 0; R.dil = 1; bh = rho >> 3; R.r = 0; R.n0 = (rho & 7) * 4; R.len = 4; }
    else if (rho < 512) { const int q = rho - 256, tri = q >> 1; R.g = 1; R.dil = 4; bh = tri >> 2; R.r = tri & 3; R.n0 = (q & 1) * 4; R.len = 4; }
    else { const int q = rho - 512; R.g = 2; R.dil = 16; bh = q >> 4; R.r = q & 15; R.n0 = 0; R.len = 2; }
    R.b = bh >> 3; R.h = bh & 7; return R;
}
__device__ __forceinline__ void attn_load_half(const u16* __restrict__ proj, const float* __restrict__ kss, const ARun& R, int k, int tid, u32x4 (&kw)[4], u32x4 (&vw)[4], float& ksr) {
    const int sb = (R.n0 + k - 1) * 128;
    const u16* kbase = proj + (size_t)R.b * SEQ * NE + 3072 + R.h * 128 + (tid & 15) * 8;
#pragma unroll
    for (int i = 0; i < 4; ++i) { int sidx = sb + (tid >> 4) + 32 * i; if (sidx < 0) sidx = 0;
        const size_t t = (size_t)R.r + (size_t)sidx * R.dil;
        kw[i] = *(const u32x4*)(kbase + t * NE); vw[i] = *(const u32x4*)(kbase + t * NE + 1024); }
    { int sidx = sb + (tid & 127); if (sidx < 0) sidx = 0; ksr = kss[((size_t)R.b * SEQ + (size_t)R.r + (size_t)sidx * R.dil) * 8 + R.h]; }
}
__device__ __forceinline__ void attn_load_q(const u16* __restrict__ proj, const ARun& R, int i, int wid, int lane, u32x4 (&qw)[4]) {
    const size_t tq = (size_t)R.r + (size_t)((R.n0 + i) * 128 + 16 * wid + (lane & 15)) * R.dil; const u16* qp = proj + ((size_t)R.b * SEQ + tq) * NE + 2048 + R.h * 128 + 8 * (lane >> 4);
#pragma unroll
    for (int ks = 0; ks < 4; ++ks) qw[ks] = *(const u32x4*)(qp + 32 * ks);
}
__device__ __forceinline__ void attn_item(LAS unsigned char* lds, const u16* __restrict__ proj, u16* __restrict__ og, float* __restrict__ lse, const float* __restrict__ kss,
                                          const float (&qgv)[4][8], const ARun& R, int i, const ARun& Rn, int in, bool nfirst,
                                          u32x4 (&kw0)[4], u32x4 (&vw0)[4], float& ks0, u32x4 (&kw1)[4], u32x4 (&vw1)[4], float& ks1, u32x4 (&qw)[4], int tid, int wid, int lane) {
    asm volatile("" : "+v"(lane), "+v"(tid));
    const int fr = lane & 15, fq = lane >> 4;
    const int g = R.g, h = R.h, dil = R.dil, r = R.r, n = R.n0 + i, par = i & 1;
    const bool first = (i == 0);
    const float slope = exp2f(-(float)(h + 1));
    const size_t rowbase = (size_t)R.b * SEQ;
    LAS unsigned char* Ks = lds;
    LAS unsigned char* Vs = lds + 69632;
    LAS float* rkL = (LAS float*)(lds + 135168);
    __syncthreads();
    {
        const int pc = tid & 15;
        const int slot0 = first ? 0 : ((i + 1) & 1);
#pragma unroll
        for (int q = 0; q < 4; ++q) { const int row = 128 * slot0 + (tid >> 4) + 32 * q;
            *(LAS u32x4*)(Ks + row * 272 + pc * 16) = kw0[q]; *(LAS u32x4*)(Vs + off_b((unsigned)row, (unsigned)pc)) = vw0[q]; }
        if (tid < 128) rkL[128 * slot0 + tid] = rsqrtf(ks0 * (1.0f / 128.0f) + EPSF);
        if (first) {
#pragma unroll
            for (int q = 0; q < 4; ++q) { const int row = 128 + (tid >> 4) + 32 * q;
                *(LAS u32x4*)(Ks + row * 272 + pc * 16) = kw1[q]; *(LAS u32x4*)(Vs + off_b((unsigned)row, (unsigned)pc)) = vw1[q]; }
            if (tid < 128) rkL[128 + tid] = rsqrtf(ks1 * (1.0f / 128.0f) + EPSF);
        }
    }
    const int qi = 16 * wid + fr;
    const size_t tq = (size_t)r + (size_t)(n * 128 + qi) * dil;
    bf16x8 qf[4];
    {
        float qv[4][8]; float ss = 0.f;
#pragma unroll
        for (int ks = 0; ks < 4; ++ks) { unpack8(qw[ks], qv[ks]);
#pragma unroll
            for (int j = 0; j < 8; ++j) ss += qv[ks][j] * qv[ks][j]; }
        ss += __shfl_xor(ss, 16); ss += __shfl_xor(ss, 32);
        const float qs = rsqrtf(ss * (1.0f / 128.0f) + EPSF) * (0.08838834764831845f * 1.4426950408889634f);
#pragma unroll
        for (int ks = 0; ks < 4; ++ks) { float t[8];
#pragma unroll
            for (int j = 0; j < 8; ++j) t[j] = qv[ks][j] * qs * qgv[ks][j];
            qf[ks] = __builtin_bit_cast(bf16x8, pack8(t)); }
    }
    __syncthreads();
    const int kt0 = 2 * (wid >> 1);
    const int px = par << 7;
    f32x4 s[10];
#pragma unroll
    for (int j = 0; j < 10; ++j) { f32x4 acc = {0.f, 0.f, 0.f, 0.f};
#pragma unroll
        for (int ks = 0; ks < 4; ++ks) { const bf16x8 kf = *(const LAS bf16x8*)(Ks + ((16 * (kt0 + j) + fr) ^ px) * 272 + (32 * ks + 8 * fq) * 2); acc = mfma16(kf, qf[ks], acc); }
        s[j] = acc; __builtin_amdgcn_sched_barrier(0); }
    const float sl2 = slope * (float)dil * 1.4426950408889634f;
    const int C0 = qi - 16 * kt0 - 4 * fq + 128;
    int LO = C0 - 128; if (n == 0) LO = max(LO, 128 - 16 * kt0 - 4 * fq);
    const unsigned range = (unsigned)(C0 - LO);
    const float b0 = -sl2 * (float)C0;
    f32x4 rk[10];
#pragma unroll
    for (int j = 0; j < 10; ++j) rk[j] = *(const LAS f32x4*)(rkL + ((16 * (kt0 + j) + 4 * fq) ^ px));
    float mx = -3.0e38f;
#pragma unroll
    for (int j = 0; j < 10; ++j)
#pragma unroll
        for (int ii = 0; ii < 4; ++ii) { const int cji = 16 * j + ii;
            const float v0 = fmaf(sl2, (float)cji, fmaf(s[j][ii], rk[j][ii], b0));
            const float v = ((unsigned)(cji - LO) <= range) ? v0 : -1.0e30f; s[j][ii] = v; mx = fmaxf(mx, v); }
    mx = fmaxf(mx, __shfl_xor(mx, 16)); mx = fmaxf(mx, __shfl_xor(mx, 32));
    float l = 0.f;
#pragma unroll
    for (int j = 0; j < 10; ++j)
#pragma unroll
        for (int ii = 0; ii < 4; ++ii) { const float p = __builtin_amdgcn_exp2f(s[j][ii] - mx); s[j][ii] = p; l += p; }
    l += __shfl_xor(l, 16); l += __shfl_xor(l, 32);
    bf16x8 pf[5];
#pragma unroll
    for (int k5 = 0; k5 < 5; ++k5) { u32x4 w; w.x = cvt_pk_bf16(s[2 * k5][0], s[2 * k5][1]); w.y = cvt_pk_bf16(s[2 * k5][2], s[2 * k5][3]);
        w.z = cvt_pk_bf16(s[2 * k5 + 1][0], s[2 * k5 + 1][1]); w.w = cvt_pk_bf16(s[2 * k5 + 1][2], s[2 * k5 + 1][3]); pf[k5] = __builtin_bit_cast(bf16x8, w); }
    attn_load_half(proj, kss, Rn, nfirst ? 0 : in + 1, tid, kw0, vw0, ks0);
    if (nfirst) attn_load_half(proj, kss, Rn, 1, tid, kw1, vw1, ks1);
    attn_load_q(proj, Rn, in, wid, lane, qw);
    f32x4 o[8];
#pragma unroll
    for (int dt = 0; dt < 8; ++dt) o[dt] = (f32x4){0.f, 0.f, 0.f, 0.f};
    {
        unsigned va_addr[8][2];
        { const unsigned q4 = ((unsigned)lane & 15u) >> 2, p4 = (unsigned)lane & 3u;
#pragma unroll
          for (int t = 0; t < 2; ++t)
#pragma unroll
            for (int dt = 0; dt < 8; ++dt) va_addr[dt][t] = (unsigned)(size_t)Vs + off_b(16u * t + 4u * fq + q4, 4u * (dt >> 1) + p4) + 8u * (dt & 1); }
#pragma unroll
        for (int k5 = 0; k5 < 5; ++k5) { const unsigned koff = 8192u * (unsigned)(((wid >> 1) + k5) ^ (par << 2)); u16x4 va[8][2];
#pragma unroll
            for (int t = 0; t < 2; ++t)
#pragma unroll
                for (int dt = 0; dt < 8; ++dt) va[dt][t] = tr_issue(va_addr[dt][t] + koff);
            asm volatile("s_waitcnt lgkmcnt(0)" : "+v"(va[0][0]), "+v"(va[0][1]), "+v"(va[1][0]), "+v"(va[1][1]), "+v"(va[2][0]), "+v"(va[2][1]), "+v"(va[3][0]), "+v"(va[3][1]),
                                                   "+v"(va[4][0]), "+v"(va[4][1]), "+v"(va[5][0]), "+v"(va[5][1]), "+v"(va[6][0]), "+v"(va[6][1]), "+v"(va[7][0]), "+v"(va[7][1]) :: "memory");
#pragma unroll
            for (int dt = 0; dt < 8; ++dt) o[dt] = mfma16(tr_join(va[dt][0], va[dt][1]), pf[k5], o[dt]);
            __builtin_amdgcn_sched_barrier(0); }
    }
    const float inv = __builtin_amdgcn_rcpf(l);
    const size_t orow = (size_t)g * MROWS + rowbase + tq;
    u16* op = og + orow * 1024 + h * 128 + 8 * fq;
#pragma unroll
    for (int T = 0; T < 4; ++T) { u32x4 w; w.x = cvt_pk_bf16(o[2 * T][0] * inv, o[2 * T][1] * inv); w.y = cvt_pk_bf16(o[2 * T][2] * inv, o[2 * T][3] * inv);
        w.z = cvt_pk_bf16(o[2 * T + 1][0] * inv, o[2 * T + 1][1] * inv); w.w = cvt_pk_bf16(o[2 * T + 1][2] * inv, o[2 * T + 1][3] * inv); *(u32x4*)(op + 32 * T) = w; }
    if (fq == 0) lse[orow * 8 + h] = (mx + __builtin_amdgcn_logf(l)) * 0.6931471805599453f;
}

__device__ __forceinline__ float ret_log_g(int h) { return __logf(1.0f - exp2f(-5.0f - (float)h)); }

__device__ __forceinline__ void ret_contrib_item(LAS unsigned char* lds, const u16* __restrict__ proj, float* __restrict__ ST, int item, int tid, int wid, int lane) {
    asm volatile("" : "+v"(lane), "+v"(tid));
    const int fr = lane & 15, fq = lane >> 4;
    const int bh = item >> 5, n = item & 31, b = bh >> 2, h = bh & 3;
    const size_t row0 = (size_t)b * SEQ + (size_t)n * 128;
    const u16* kbase = proj + row0 * NE + 512 + h * 128;
    const u16* vbase = proj + row0 * NE + 1024 + h * 256;
    const float lg = ret_log_g(h);
    LAS unsigned char* Ks = lds;
    LAS unsigned char* Vs = lds + 32768;
    u32x4 kw[4], vw[8];
#pragma unroll
    for (int i = 0; i < 4; ++i) { const int p = tid + 512 * i; kw[i] = *(const u32x4*)(kbase + (size_t)(p >> 4) * NE + (p & 15) * 8); }
#pragma unroll
    for (int i = 0; i < 8; ++i) { const int p = tid + 512 * i; vw[i] = *(const u32x4*)(vbase + (size_t)(p >> 5) * NE + (p & 31) * 8); }
    __syncthreads();
#pragma unroll
    for (int i = 0; i < 4; ++i) { const int p = tid + 512 * i, sI = p >> 4, pc = p & 15;
        const float zs = __expf(lg * (float)(127 - sI)) * 0.08838834764831845f;
        float f[8]; unpack8(kw[i], f);
#pragma unroll
        for (int j = 0; j < 8; ++j) f[j] *= zs;
        *(LAS u32x4*)(Ks + off_b((unsigned)sI, (unsigned)pc)) = pack8(f); }
#pragma unroll
    for (int i = 0; i < 8; ++i) { const int p = tid + 512 * i, sI = p >> 5, pc = p & 31;
        *(LAS u32x4*)(Vs + (pc >> 4) * 32768 + off_b((unsigned)sI, (unsigned)(pc & 15))) = vw[i]; }
    __syncthreads();
    f32x4 acc[2][8];
#pragma unroll
    for (int mt = 0; mt < 2; ++mt)
#pragma unroll
        for (int nt = 0; nt < 8; ++nt) acc[mt][nt] = (f32x4){0.f, 0.f, 0.f, 0.f};
    const unsigned kb = (unsigned)(size_t)Ks, vb = (unsigned)(size_t)Vs + (unsigned)(wid >> 2) * 32768u;
#pragma unroll
    for (int ks = 0; ks < 4; ++ks) {
        u16x4 ka[8][2], va[2][2];
#pragma unroll
        for (int t = 0; t < 2; ++t) {
#pragma unroll
            for (int nt = 0; nt < 8; ++nt) ka[nt][t] = tr_issue(tr_addr(kb, lane, ks, nt, t));
#pragma unroll
            for (int mt = 0; mt < 2; ++mt) va[mt][t] = tr_issue(tr_addr(vb, lane, ks, 2 * (wid & 3) + mt, t)); }
        asm volatile("s_waitcnt lgkmcnt(0)" : "+v"(ka[0][0]), "+v"(ka[0][1]), "+v"(ka[1][0]), "+v"(ka[1][1]), "+v"(ka[2][0]), "+v"(ka[2][1]), "+v"(ka[3][0]), "+v"(ka[3][1]),
                                               "+v"(ka[4][0]), "+v"(ka[4][1]), "+v"(ka[5][0]), "+v"(ka[5][1]), "+v"(ka[6][0]), "+v"(ka[6][1]), "+v"(ka[7][0]), "+v"(ka[7][1]),
                                               "+v"(va[0][0]), "+v"(va[0][1]), "+v"(va[1][0]), "+v"(va[1][1]) :: "memory");
        const bf16x8 vf0 = tr_join(va[0][0], va[0][1]), vf1 = tr_join(va[1][0], va[1][1]);
#pragma unroll
        for (int nt = 0; nt < 8; ++nt) { const bf16x8 kf = tr_join(ka[nt][0], ka[nt][1]); acc[0][nt] = mfma16(kf, vf0, acc[0][nt]); acc[1][nt] = mfma16(kf, vf1, acc[1][nt]); }
        __builtin_amdgcn_sched_barrier(0); }
    float* out = ST + (size_t)item * 32768;
#pragma unroll
    for (int mt = 0; mt < 2; ++mt)
#pragma unroll
        for (int nt = 0; nt < 8; ++nt) *(f32x4*)(out + (32 * wid + 16 * mt + fr) * 128 + 16 * nt + 4 * fq) = acc[mt][nt];
}

__device__ __forceinline__ void ret_out_item(LAS unsigned char* lds, const u16* __restrict__ proj, const u16* __restrict__ RT, const float* __restrict__ gn, u16* __restrict__ y0,
                                             int item, int tid, int wid, int lane) {
    asm volatile("" : "+v"(lane), "+v"(tid));
    const int fr = lane & 15, fq = lane >> 4;
    const int bh = item >> 5, n = item & 31, b = bh >> 2, h = bh & 3;
    const size_t row0 = (size_t)b * SEQ + (size_t)n * 128;
    const u16* qbase = proj + row0 * NE + h * 128;
    const u16* kbase = proj + row0 * NE + 512 + h * 128;
    const u16* vbase = proj + row0 * NE + 1024 + h * 256;
    const u16* zbase = proj + row0 * NE + 5120 + h * 256;
    const u16* rtb = RT + (size_t)item * 32768;
    const float lg = ret_log_g(h);
    LAS unsigned char* Ks = lds;
    LAS unsigned char* Ps = lds + 34816;
    LAS unsigned char* Vh = lds + 69632;
    LAS unsigned char* Rh = lds + 102400;
    u32x4 kw[4], vw[4], rw[4];
#pragma unroll
    for (int i = 0; i < 4; ++i) { const int p = tid + 512 * i, sI = p >> 4, pc = p & 15;
        kw[i] = *(const u32x4*)(kbase + (size_t)sI * NE + pc * 8); vw[i] = *(const u32x4*)(vbase + (size_t)sI * NE + pc * 8); rw[i] = *(const u32x4*)(rtb + (size_t)sI * 128 + pc * 8); }
    const int c = 16 * wid + fr;
    bf16x8 qf[4], qx[4];
    {
        const u16* qp = qbase + (size_t)c * NE; const float xi = __expf(lg * (float)(c + 1));
#pragma unroll
        for (int ks = 0; ks < 4; ++ks) { const u32x4 w = *(const u32x4*)(qp + 32 * ks + 8 * fq); qf[ks] = __builtin_bit_cast(bf16x8, w);
            float f[8]; unpack8(w, f);
#pragma unroll
            for (int j = 0; j < 8; ++j) f[j] *= xi;
            qx[ks] = __builtin_bit_cast(bf16x8, pack8(f)); }
    }
    __syncthreads();
#pragma unroll
    for (int i = 0; i < 4; ++i) { const int p = tid + 512 * i, sI = p >> 4, pc = p & 15;
        *(LAS u32x4*)(Ks + sI * 272 + pc * 16) = kw[i]; *(LAS u32x4*)(Vh + off_b((unsigned)sI, (unsigned)pc)) = vw[i]; *(LAS u32x4*)(Rh + sI * 272 + pc * 16) = rw[i]; }
#pragma unroll
    for (int i = 0; i < 4; ++i) { const int p = tid + 512 * i, sI = p >> 4, pc = p & 15;
        vw[i] = *(const u32x4*)(vbase + (size_t)sI * NE + 128 + pc * 8); rw[i] = *(const u32x4*)(rtb + (size_t)(128 + sI) * 128 + pc * 8); }
    __syncthreads();
#pragma unroll
    for (int st = 0; st < 8; ++st) {
        u32x2 w; w.x = 0u; w.y = 0u;
        if (st <= wid) { f32x4 acc = {0.f, 0.f, 0.f, 0.f};
#pragma unroll
            for (int ks = 0; ks < 4; ++ks) { const bf16x8 kf = *(const LAS bf16x8*)(Ks + (16 * st + fr) * 272 + (32 * ks + 8 * fq) * 2); acc = mfma16(kf, qf[ks], acc); }
            float pv[4];
#pragma unroll
            for (int i = 0; i < 4; ++i) { const int d = c - (16 * st + 4 * fq + i); pv[i] = (d >= 0) ? acc[i] * 0.08838834764831845f * __expf(lg * (float)d) : 0.f; }
            w.x = cvt_pk_bf16(pv[0], pv[1]); w.y = cvt_pk_bf16(pv[2], pv[3]); }
        *(LAS u32x2*)(Ps + c * 272 + (16 * st + 4 * fq) * 2) = w; __builtin_amdgcn_sched_barrier(0);
    }
    f32x4 y[2][8];
#pragma unroll
    for (int hf = 0; hf < 2; ++hf)
#pragma unroll
        for (int vt = 0; vt < 8; ++vt) y[hf][vt] = (f32x4){0.f, 0.f, 0.f, 0.f};
    const unsigned vhb = (unsigned)(size_t)Vh;
#pragma unroll
    for (int hf = 0; hf < 2; ++hf) {
        if (hf == 1) {
            __syncthreads();
#pragma unroll
            for (int i = 0; i < 4; ++i) { const int p = tid + 512 * i, sI = p >> 4, pc = p & 15;
                *(LAS u32x4*)(Vh + off_b((unsigned)sI, (unsigned)pc)) = vw[i]; *(LAS u32x4*)(Rh + sI * 272 + pc * 16) = rw[i]; }
            __syncthreads();
        }
#pragma unroll
        for (int ks = 0; ks < 4; ++ks) { const bf16x8 pf = *(const LAS bf16x8*)(Ps + c * 272 + (32 * ks + 8 * fq) * 2);
            u16x4 va[8][2];
#pragma unroll
            for (int t = 0; t < 2; ++t)
#pragma unroll
                for (int vt = 0; vt < 8; ++vt) va[vt][t] = tr_issue(tr_addr(vhb, lane, ks, vt, t));
            asm volatile("s_waitcnt lgkmcnt(0)" : "+v"(va[0][0]), "+v"(va[0][1]), "+v"(va[1][0]), "+v"(va[1][1]), "+v"(va[2][0]), "+v"(va[2][1]), "+v"(va[3][0]), "+v"(va[3][1]),
                                                   "+v"(va[4][0]), "+v"(va[4][1]), "+v"(va[5][0]), "+v"(va[5][1]), "+v"(va[6][0]), "+v"(va[6][1]), "+v"(va[7][0]), "+v"(va[7][1]) :: "memory");
#pragma unroll
            for (int vt = 0; vt < 8; ++vt) y[hf][vt] = mfma16(tr_join(va[vt][0], va[vt][1]), pf, y[hf][vt]);
            __builtin_amdgcn_sched_barrier(0); }
#pragma unroll
        for (int ks = 0; ks < 4; ++ks) {
#pragma unroll
            for (int vt = 0; vt < 8; ++vt) { const bf16x8 rf = *(const LAS bf16x8*)(Rh + (16 * vt + fr) * 272 + (32 * ks + 8 * fq) * 2); y[hf][vt] = mfma16(rf, qx[ks], y[hf][vt]); } __builtin_amdgcn_sched_barrier(0); }
#pragma unroll
        for (int vt = 0; vt < 8; ++vt) asm volatile("" : "+v"(y[hf][vt]));
    }
    float sum = 0.f;
#pragma unroll
    for (int hf = 0; hf < 2; ++hf)
#pragma unroll
        for (int vt = 0; vt < 8; ++vt) sum += (y[hf][vt][0] + y[hf][vt][1]) + (y[hf][vt][2] + y[hf][vt][3]);
    sum += __shfl_xor(sum, 16); sum += __shfl_xor(sum, 32);
    const float mu = sum * (1.0f / 256.0f);
    float var = 0.f;
#pragma unroll
    for (int hf = 0; hf < 2; ++hf)
#pragma unroll
        for (int vt = 0; vt < 8; ++vt) { const f32x4 d = y[hf][vt] - mu; var += (d[0] * d[0] + d[1] * d[1]) + (d[2] * d[2] + d[3] * d[3]); }
    var += __shfl_xor(var, 16); var += __shfl_xor(var, 32);
    const float rstd = rsqrtf(var * (1.0f / 256.0f) + EPSF);
    const u16* zp = zbase + (size_t)c * NE;
    u16* yp = y0 + (row0 + c) * DM + h * 256;
#pragma unroll
    for (int hf = 0; hf < 2; ++hf)
#pragma unroll
        for (int vt = 0; vt < 8; ++vt) { const int v = 128 * hf + 16 * vt + 4 * fq;
            const f32x4 gv = *(const f32x4*)(gn + h * 256 + v); const u32x2 zw = *(const u32x2*)(zp + v);
            const float z0 = bflo(zw.x), z1 = bfhi(zw.x), z2 = bflo(zw.y), z3 = bfhi(zw.y);
            const f32x4 t = (y[hf][vt] - mu) * rstd * gv;
            u32x2 w; w.x = cvt_pk_bf16(t[0] * silu_f(z0), t[1] * silu_f(z1)); w.y = cvt_pk_bf16(t[2] * silu_f(z2), t[3] * silu_f(z3));
            *(u32x2*)(yp + v) = w; }
}

#define XB_TMO      128
#define XB_XCNT(j)  (256  + 64 * (j))
#define XB_XSUB(j)  (1280 + 64 * (j))
#define XB_XGEN(j)  (2304 + 64 * (j))
#define XB_TOP      3328
#define XB_TOPGEN   3392
#define XCD_BAR_WORDS 3456
#define XB_SPIN_CAP (1u << 18)


__device__ __forceinline__ unsigned xb_ld(unsigned* p)              { return __hip_atomic_load(p, __ATOMIC_RELAXED, __HIP_MEMORY_SCOPE_AGENT); }
__device__ __forceinline__ unsigned xb_add(unsigned* p, unsigned v) { return __hip_atomic_fetch_add(p, v, __ATOMIC_RELAXED, __HIP_MEMORY_SCOPE_AGENT); }
__device__ __forceinline__ unsigned xb_xcc_id() { return (unsigned)__builtin_amdgcn_s_getreg((3 << 11) | 20) & 0xFu; }
#define XB_SPIN(cond, bar) do { unsigned _sp = 0; while (cond) { __builtin_amdgcn_s_sleep(1); \
    if ((++_sp & 255u) == 0u) { if (xb_ld(&(bar)[XB_TMO])) break; if (_sp > XB_SPIN_CAP) { atomicAdd(&(bar)[XB_TMO], 1u); break; } } } } while (0)

struct XcdBarrier {
    unsigned* bar; unsigned x;
    volatile LAS unsigned* st;
};

__device__ __forceinline__ XcdBarrier xcd_barrier_post(unsigned* bar, volatile LAS unsigned* st) {
    XcdBarrier b; b.bar = bar; b.x = xb_xcc_id(); b.st = st;
    if (threadIdx.x == 0) (void)xb_add(&bar[XB_XCNT(b.x)], 1u);
    return b;
}
__device__ __forceinline__ void xcd_barrier_complete(unsigned* bar, unsigned x, unsigned& nloc, unsigned& nx) {
    const unsigned G = gridDim.x * gridDim.y * gridDim.z;
    unsigned sum, cnt, mine, sp = 0u;
    for (;;) {
        sum = 0u; cnt = 0u; mine = 0u;
#pragma unroll
        for (unsigned j = 0; j < 16; ++j) { const unsigned c = xb_ld(&bar[XB_XCNT(j)]); sum += c; cnt += (c > 0u) ? 1u : 0u; mine = (j == x) ? c : mine; }
        if (sum == G) break;
        __builtin_amdgcn_s_sleep(1);
        if ((++sp & 255u) == 0u) { if (xb_ld(&bar[XB_TMO])) break; if (sp > XB_SPIN_CAP) { atomicAdd(&bar[XB_TMO], 1u); break; } }
    }
    nloc = mine > 0u ? mine : 1u; nx = cnt > 0u ? cnt : 1u;
}

__device__ __forceinline__ void xcd_barrier(const XcdBarrier& b) {
    asm volatile("s_waitcnt vmcnt(0)" ::: "memory");
    __syncthreads();
    if (threadIdx.x == 0) {
        unsigned* bar = b.bar;
        __builtin_amdgcn_s_waitcnt(0);
        unsigned nloc = b.st[0], nx = b.st[1];
        if (nloc == 0u) { xcd_barrier_complete(bar, b.x, nloc, nx); b.st[0] = nloc; b.st[1] = nx; }
        const unsigned old = xb_add(&bar[XB_XSUB(b.x)], 1u);
        const unsigned gen = old / nloc;
        if (old + 1u == (gen + 1u) * nloc) {
            __builtin_amdgcn_fence(__ATOMIC_RELEASE, "agent");
            asm volatile("s_waitcnt vmcnt(0)" ::: "memory");
            const unsigned og = xb_add(&bar[XB_TOP], 1u);
            const unsigned tg = og / nx;
            if (og + 1u == (tg + 1u) * nx) xb_add(&bar[XB_TOPGEN], 1u);
            else XB_SPIN(xb_ld(&bar[XB_TOPGEN]) == tg, bar);
            __builtin_amdgcn_fence(__ATOMIC_ACQUIRE, "agent");
            xb_add(&bar[XB_XGEN(b.x)], 1u);
            asm volatile("s_waitcnt vmcnt(0)" ::: "memory");
        } else {
            XB_SPIN(xb_ld(&bar[XB_XGEN(b.x)]) == gen, bar);
            __builtin_amdgcn_fence(__ATOMIC_ACQUIRE, "agent");
            asm volatile("s_waitcnt vmcnt(0)" ::: "memory");
        }
    }
    __syncthreads();
}


__global__ void __launch_bounds__(512) hybrid_fwd(Params P) {
    cg::grid_group grid = cg::this_grid();
    extern __shared__ __attribute__((aligned(16))) unsigned char smem[];
    LAS unsigned char* lds = (LAS unsigned char*)smem;
    const int bid = blockIdx.x, G = gridDim.x;
    const float* x = P.in[0]; const float* p = P.in[1]; const float* pre_g = P.in[2]; const float* w_in_e = P.in[3];
    const float* q_g = P.in[4]; const float* k_g = P.in[5]; const float* gn_g = P.in[6]; const float* w_out_e = P.in[7];
    const float* w_in_o = P.in[8]; const float* conv_w = P.in[9]; const float* w_out_o = P.in[10]; const float* ple_g = P.in[11];
    const float* w_gate = P.in[12]; const float* w_pp = P.in[13];
    float* out = P.out;

    volatile LAS unsigned* xb_st = (volatile LAS unsigned*)(lds + 139264);
    if (threadIdx.x == 0) { xb_st[0] = 0u; xb_st[1] = 0u; }
    __syncthreads();
    unsigned* xb_words = (unsigned*)(P.ws + WS_BAR);
    XcdBarrier xb; xb.bar = xb_words; xb.x = 0u; xb.st = xb_st;
    for (int step = 0; step < P.nsched; ++step) {
        if (step == 0 && bid == 0) for (int i = threadIdx.x; i < XCD_BAR_WORDS; i += 512) xb_words[i] = 0u;
        const int ph = (int)((P.sched >> (4 * step)) & 15ull);
        int tid = threadIdx.x; asm volatile("" : "+v"(tid));
        const int wid = __builtin_amdgcn_readfirstlane(tid >> 6), lane = tid & 63;
        const size_t gtid = (size_t)bid * 512 + tid, gthreads = (size_t)G * 512;
        __attribute__((address_space(1))) unsigned char* wsg = (__attribute__((address_space(1))) unsigned char*)P.ws; asm volatile("" : "+s"(wsg));
        unsigned char* ws = (unsigned char*)wsg;
        u16* WT_IN = (u16*)(ws + WS_WT_IN); u16* WT_O0 = (u16*)(ws + WS_WT_O0); u16* WT_O1 = (u16*)(ws + WS_WT_O1);
        u16* WT_G0 = (u16*)(ws + WS_WT_G0); u16* WT_G1 = (u16*)(ws + WS_WT_G1); u16* WT_P0 = (u16*)(ws + WS_WT_P0); u16* WT_P1 = (u16*)(ws + WS_WT_P1);
        u16* PROJ = (u16*)(ws + WS_PROJ); u16* XA = (u16*)(ws + WS_XA); u16* XB = (u16*)(ws + WS_XB); u16* PBF = (u16*)(ws + WS_PBF);
        float* RS = (float*)(ws + WS_RS); float* LSE = (float*)(ws + WS_LSE); float* KSS = (float*)(ws + WS_KSS);
        u16* OG = (u16*)out;
        float* ST = (float*)XA;
        u16* RT = XB;
        if (EN_P0 && ph == 0) {
            {
                constexpr int I_IN = 32 * 112, I_SQ = 32 * 32, I_P = 4 * 32;
                constexpr int NIT = I_IN + 4 * I_SQ + 2 * I_P;
                auto dec = [=](int r) -> TJob {
                    if (r < I_IN) return TJob{w_in_e, WT_IN, pre_g, 2048, NE, r, 2}; r -= I_IN;
                    if (r < I_SQ) return TJob{w_out_e, WT_O0, nullptr, 2048, 2048, r, 2}; r -= I_SQ;
                    if (r < I_SQ) return TJob{w_out_o, WT_O1, nullptr, 2048, 2048, r, 2}; r -= I_SQ;
                    if (r < I_SQ) return TJob{w_gate, WT_G0, ple_g, 2048, 2048, r, 2}; r -= I_SQ;
                    if (r < I_SQ) return TJob{w_gate + (size_t)2048 * 2048, WT_G1, ple_g + 2048, 2048, 2048, r, 2}; r -= I_SQ;
                    if (r < I_P) return TJob{w_pp, WT_P0, nullptr, 256, 2048, r, 2}; r -= I_P;
                    return TJob{w_pp + (size_t)256 * 2048, WT_P1, nullptr, 256, 2048, r, 2}; };
                transpose_run(dec, NIT, (LAS float*)lds, bid, G, tid);
            }
            for (int row = bid * 8 + wid; row < MROWS; row += G * 8) { const float* xr = x + (size_t)row * DM; u16* orow = XA + (size_t)row * DM; float ss = 0.f;
#pragma unroll
                for (int j = 0; j < 8; ++j) { const int col = 4 * lane + 256 * j; const f32x4 v = __builtin_nontemporal_load((const f32x4*)(xr + col));
                    ss += (v[0] * v[0] + v[1] * v[1]) + (v[2] * v[2] + v[3] * v[3]);
                    u32x2 w; w.x = cvt_pk_bf16(v[0], v[1]); w.y = cvt_pk_bf16(v[2], v[3]); *(u32x2*)(orow + col) = w; }
#pragma unroll
                for (int o = 1; o < 64; o <<= 1) ss += __shfl_xor(ss, o);
                if (lane == 0) RS[row] = ss; }
            for (size_t i0 = gtid; i0 < (size_t)2 * MROWS * 256 / 8; i0 += 4 * gthreads) { f32x4 a[4], b2[4];
#pragma unroll
                for (int q = 0; q < 4; ++q) { size_t i = i0 + (size_t)q * gthreads; if (i >= (size_t)2 * MROWS * 256 / 8) i = i0; a[q] = __builtin_nontemporal_load((const f32x4*)(p + i * 8)); b2[q] = __builtin_nontemporal_load((const f32x4*)(p + i * 8 + 4)); }
#pragma unroll
                for (int q = 0; q < 4; ++q) { const size_t i = i0 + (size_t)q * gthreads; if (i < (size_t)2 * MROWS * 256 / 8) {
                    u32x4 w; w.x = cvt_pk_bf16(a[q][0], a[q][1]); w.y = cvt_pk_bf16(a[q][2], a[q][3]); w.z = cvt_pk_bf16(b2[q][0], b2[q][1]); w.w = cvt_pk_bf16(b2[q][2], b2[q][3]); *(u32x4*)(PBF + i * 8) = w; } } }
            for (size_t i = gtid; i < (size_t)3 * MROWS; i += gthreads) RS[MROWS + i] = 0.f;
            for (size_t i = gtid; i < (size_t)8 * MROWS; i += gthreads) KSS[i] = 0.f;
        }
        if (EN_P2 && ph == 2) {
            u32x4 kw0[4], vw0[4], kw1[4], vw1[4], qw[4]; float ks0, ks1;
            for (int it = bid; it < 512; it += G) ret_contrib_item(lds, PROJ, ST, it, tid, wid, lane);
            float qgv[4][8];
#pragma unroll
            for (int ks = 0; ks < 4; ++ks)
#pragma unroll
                for (int j = 0; j < 8; ++j) qgv[ks][j] = q_g[32 * ks + 8 * (lane >> 4) + j] * k_g[32 * ks + 8 * (lane >> 4) + j];
            { const ARun R0 = attn_run(bid < 1024 ? bid : 1023);
              attn_load_half(PROJ, KSS, R0, 0, tid, kw0, vw0, ks0); attn_load_half(PROJ, KSS, R0, 1, tid, kw1, vw1, ks1); attn_load_q(PROJ, R0, 0, wid, lane, qw); }
            for (int rho = bid; rho < 1024; rho += G) { const ARun R = attn_run(rho); const ARun Rnext = attn_run(rho + G < 1024 ? rho + G : rho);
                for (int i = 0; i < R.len; ++i) { const bool last = (i + 1 == R.len);
                    attn_item(lds, PROJ, OG, LSE, KSS, qgv, R, i, last ? Rnext : R, last ? 0 : i + 1, last, kw0, vw0, ks0, kw1, vw1, ks1, qw, tid, wid, lane); } }
        }
        if (EN_P3 && ph == 3) {
            for (size_t i = gtid; i < (size_t)16 * 8192; i += gthreads) { const int bh = (int)(i >> 13), e4 = (int)(i & 8191); const float gc = __expf(ret_log_g(bh & 3) * 128.0f);
                const float* sp = ST + (size_t)bh * 32 * 32768 + (size_t)e4 * 4; u16* rp = RT + (size_t)bh * 32 * 32768 + (size_t)e4 * 4;
                f32x4 R = {0.f, 0.f, 0.f, 0.f};
                for (int n0 = 0; n0 < 32; n0 += 8) { f32x4 sv[8];
#pragma unroll
                    for (int q = 0; q < 8; ++q) sv[q] = __builtin_nontemporal_load((const f32x4*)(sp + (size_t)(n0 + q) * 32768));
#pragma unroll
                    for (int q = 0; q < 8; ++q) { u32x2 w; w.x = cvt_pk_bf16(R[0], R[1]); w.y = cvt_pk_bf16(R[2], R[3]); *(u32x2*)(rp + (size_t)(n0 + q) * 32768) = w; R = R * gc + sv[q]; } } }
        }
        if (EN_P4 && ph == 4) {
            auto merge_patterns = [&]() {
                __syncthreads();
                { auto dec = [=](int r) -> TJob { return TJob{w_in_o, WT_IN, pre_g + 2048, 2048, NO, r, 1}; }; transpose_run(dec, 32 * 128, (LAS float*)lds, bid, G, tid); }
            for (size_t i0 = gtid; i0 < (size_t)MROWS * 128; i0 += 4 * gthreads) {
                u32x4 w0[4], w1[4], w2[4], wz[4]; float l0[4], l1[4], l2[4];
#pragma unroll
                for (int q = 0; q < 4; ++q) { size_t i = i0 + (size_t)q * gthreads; if (i >= (size_t)MROWS * 128) i = i0; const size_t row = i >> 7; const int c8 = (int)(i & 127), h = c8 >> 4, col = c8 * 8;
                    l0[q] = LSE[row * 8 + h]; l1[q] = LSE[((size_t)MROWS + row) * 8 + h]; l2[q] = LSE[((size_t)2 * MROWS + row) * 8 + h];
                    w0[q] = __builtin_nontemporal_load((const u32x4*)(OG + row * 1024 + col)); w1[q] = __builtin_nontemporal_load((const u32x4*)(OG + ((size_t)MROWS + row) * 1024 + col));
                    w2[q] = __builtin_nontemporal_load((const u32x4*)(OG + ((size_t)2 * MROWS + row) * 1024 + col)); wz[q] = __builtin_nontemporal_load((const u32x4*)(PROJ + row * NE + 6144 + col)); }
#pragma unroll
                for (int q = 0; q < 4; ++q) { const size_t i = i0 + (size_t)q * gthreads; if (i < (size_t)MROWS * 128) { const size_t row = i >> 7; const int col = (int)(i & 127) * 8;
                    const float mm = fmaxf(l0[q], fmaxf(l1[q], l2[q])); float e0 = __expf(l0[q] - mm), e1 = __expf(l1[q] - mm), e2 = __expf(l2[q] - mm); const float inv = __builtin_amdgcn_rcpf(e0 + e1 + e2);
                    e0 *= inv; e1 *= inv; e2 *= inv;
                    float a0[8], a1[8], a2[8], zf[8], r[8];
                    unpack8(w0[q], a0); unpack8(w1[q], a1); unpack8(w2[q], a2); unpack8(wz[q], zf);
#pragma unroll
                    for (int j = 0; j < 8; ++j) r[j] = (e0 * a0[j] + e1 * a1[j] + e2 * a2[j]) * silu_f(zf[j]);
                    *(u32x4*)(XA + row * DM + 1024 + col) = pack8(r); } }
            }
            };
            if (bid & 1) merge_patterns();
            for (int it = bid; it < 512; it += G) ret_out_item(lds, PROJ, RT, gn_g, XA, it, tid, wid, lane);
            if (!(bid & 1)) merge_patterns();
        }
        for (int pass = 0; pass < 2; ++pass) {
        const bool both = (ph == 5 || ph == 9), resid_turn = both && ((pass == 0) == ((bid & 1) == 0));
        if (EN_GR && resid_turn) {
            const bool l1 = (ph == 9);
            if (l1) {
                const float* VS = (const float*)(PROJ + SIDE_OFF); const float* WS = VS + (size_t)256 * 4 * 2048;
                pg8::StaticOrder so0; so0.init(MROWS, DM, G, bid); pg8::Unit uu;
                for (int ui = 0; so0.next(ui, uu); ++ui) {
                    bool seen = false; { pg8::Unit up; for (int uj = 0; uj < ui; ++uj) { so0.next(uj, up); seen = seen || (up.pm == uu.pm); } }
                    if (seen) continue;
                    for (int i = tid; i < 4 * 2 * 512; i += 512) { const int c4 = (i & 511) * 4, fr = (i >> 9) & 1; const size_t b64 = (size_t)uu.pm * 4 + (i >> 10);
                        const bool first = (b64 & 63) == 0;
                        const f32x4 z4 = {0.f, 0.f, 0.f, 0.f};
                        const f32x4 v = *(const f32x4*)(VS + (b64 * 4 + fr) * 2048 + c4), wv = *(const f32x4*)(WS + (b64 * 2 + fr) * 2048 + c4);
                        f32x4 v1, v2;
                        if (fr == 0) { v1 = first ? z4 : *(const f32x4*)(VS + ((b64 - 1) * 4 + 3) * 2048 + c4); v2 = first ? z4 : *(const f32x4*)(VS + ((b64 - 1) * 4 + 2) * 2048 + c4); }
                        else { v1 = *(const f32x4*)(VS + (b64 * 4 + 0) * 2048 + c4); v2 = first ? z4 : *(const f32x4*)(VS + ((b64 - 1) * 4 + 3) * 2048 + c4); }
                        const f32x4 c0 = *(const f32x4*)(conv_w + c4), c1 = *(const f32x4*)(conv_w + 2048 + c4), c2 = *(const f32x4*)(conv_w + 4096 + c4);
                        const f32x4 y = wv * (c2 * v + c1 * v1 + c0 * v2);
                        u32x2 w; w.x = cvt_pk_bf16(y[0], y[1]); w.y = cvt_pk_bf16(y[2], y[3]); *(u32x2*)(XB + (b64 * 64 + fr) * DM + c4) = w; }
                }
                asm volatile("s_waitcnt vmcnt(0)" ::: "memory"); __syncthreads();
            }
            pg8::Gemm g{l1 ? XB : XA, l1 ? WT_O1 : WT_O0, MROWS, DM, 2048, 2048, 2048}; pg8::StaticOrder so; so.init(MROWS, DM, G, bid);
            if (l1) { pg8::EpiResid<false> e{nullptr, XA, XA, RS + 3 * MROWS}; pg8::gemm_phase<pg8::EpiResid<false>, pg8::StaticOrder, false>(lds, g, so, e, nullptr); }
            else { pg8::EpiResid<true> e{x, XA, XB, RS + 1 * MROWS}; pg8::gemm_phase<pg8::EpiResid<true>, pg8::StaticOrder, false>(lds, g, so, e, nullptr); }
        }
        if (EN_GS && ((both && !resid_turn) || (pass == 0 && (ph == 1 || ph == 7)))) {
            pg8::Gemm g; pg8::EpiScaleBf16 e; int N;
            if (ph == 1) { g = pg8::Gemm{XA, WT_IN, MROWS, NE, 2048, 2048, 2048}; e = pg8::EpiScaleBf16{PROJ, NE, RS, nullptr, nullptr, nullptr, KSS}; N = NE; }
            else if (ph == 7) { g = pg8::Gemm{XA, WT_IN, MROWS, NO, 2048, 2048, 2048}; e = pg8::EpiScaleBf16{XB, DM, RS + 2 * MROWS, conv_w, (float*)(PROJ + SIDE_OFF), (float*)(PROJ + SIDE_OFF) + (size_t)256 * 4 * 2048, nullptr}; N = NO; }
            else { const bool l1 = (ph == 9); g = pg8::Gemm{PBF + (l1 ? (size_t)MROWS * 256 : 0), l1 ? WT_P1 : WT_P0, MROWS, DM, 256, 256, 256}; e = pg8::EpiScaleBf16{PROJ, DM, nullptr, nullptr, nullptr, nullptr, nullptr}; N = DM; }
            pg8::StaticOrder so; so.init(MROWS, N, G, bid);
            pg8::gemm_phase<pg8::EpiScaleBf16, pg8::StaticOrder, false>(lds, g, so, e, nullptr);
        }
        }
        if (EN_GG && (ph == 6 || ph == 10)) {
            const bool l1 = (ph == 10);
            pg8::Gemm g{l1 ? XA : XB, l1 ? WT_G1 : WT_G0, MROWS, DM, 2048, 2048, 2048}; pg8::StaticOrder so; so.init(MROWS, DM, G, bid);
            pg8::EpiGate e{RS + (l1 ? 3 : 1) * MROWS, PROJ, l1 ? XA : XB, XA, l1 ? out : (float*)nullptr, RS + 2 * MROWS};
            pg8::gemm_phase<pg8::EpiGate, pg8::StaticOrder, false>(lds, g, so, e, nullptr);
        }
        if (step + 1 < P.nsched) { if (step == 0) { grid.sync(); xb = xcd_barrier_post(xb_words, xb_st); } else xcd_barrier(xb); }
    }
}

extern "C" void kernel_launch(void* const* d_in, const int* in_sizes, int n_in, void* d_out, int out_size, void* d_ws, size_t ws_size, hipStream_t stream) {
    static int grid = 0;
    if (grid == 0) {
        if (n_in != 14 || out_size != MROWS * DM || ws_size < WS_END) { fprintf(stderr, "kernel_launch: unexpected shapes (n_in %d out %d ws %zu need %zu)\n", n_in, out_size, ws_size, (size_t)WS_END); grid = -1; return; }
        int dev = 0, cus = 0, per_cu = 0;
        hipGetDevice(&dev); hipDeviceGetAttribute(&cus, hipDeviceAttributeMultiprocessorCount, dev);
        if (hipFuncSetAttribute((const void*)hybrid_fwd, hipFuncAttributeMaxDynamicSharedMemorySize, LDS_BYTES) != hipSuccess) { fprintf(stderr, "kernel_launch: hipFuncSetAttribute failed\n"); grid = -1; return; }
        if (hipOccupancyMaxActiveBlocksPerMultiprocessor(&per_cu, (const void*)hybrid_fwd, 512, LDS_BYTES) != hipSuccess || per_cu < 1) { fprintf(stderr, "kernel_launch: occupancy query says %d\n", per_cu); (void)hipGetLastError(); per_cu = 1; }
        grid = cus * per_cu;
    }
    if (grid < 0) return;
    Params P{};
    for (int i = 0; i < 14; ++i) P.in[i] = (const float*)d_in[i];
    P.out = (float*)d_out; P.ws = (unsigned char*)d_ws; P.sched = SCHED_BITS; P.nsched = SCHED_N;
    void* args[] = {&P};
    hipError_t e = hipLaunchCooperativeKernel((const void*)hybrid_fwd, dim3(grid), dim3(512), args, LDS_BYTES, stream);
    if (e != hipSuccess) fprintf(stderr, "cooperative launch failed: %s (grid %d)\n", hipGetErrorString(e), grid);
}
```

```cpp
#include <hip/hip_runtime.h>
#include <hip/hip_cooperative_groups.h>
#include <cstdio>
namespace cg = cooperative_groups;
namespace pg8 {
#define PG8_LAS __attribute__((address_space(3)))
typedef unsigned short bf16_t;
typedef short bf16x8 __attribute__((ext_vector_type(8)));
typedef float f32x4 __attribute__((ext_vector_type(4)));
typedef unsigned u32x4 __attribute__((ext_vector_type(4)));
constexpr int BM = 256, BK = 64, HALF = 128, HTB = HALF * BK * 2  , STAGE_BYTES = 8 * HTB, NXCD = 8, WGM = 4;

__host__ __device__ __forceinline__ int lds_byte(int r, int c) { const int st = (r >> 4) * 2 + (c >> 5), rr = r & 15, cc = c & 31, ob = rr * 64 + cc * 2; return st * 1024 + (ob ^ (((ob >> 9) & 1) << 5)); }
__host__ __device__ __forceinline__ void stage_rc(int b, int& R, int& C) { const int st = b / 1024, sb = b % 1024, swz = sb ^ (((sb >> 9) & 1) << 5); R = (st >> 1) * 16 + swz / 64; C = (st & 1) * 32 + (swz % 64) / 2; }
__host__ __device__ __forceinline__ int perm32(int rho) { const int n = rho >> 4, i = rho & 15; return 8 * (i >> 2) + 4 * n + (i & 3); }

struct Unit { int pm, pn; };
struct Gemm { const bf16_t* A; const bf16_t* Bt; int M, N, K, ldA, ldB; };

struct StaticOrder {
    int nM, nN, nwg, G, c;
    __host__ __device__ void init(int M, int N, int G_, int c_) { nM = M / BM; nN = N / BM; nwg = nM * nN; G = G_; c = c_; }
    __host__ __device__ bool next(int i, Unit& u) const {
        const long L = (long)i * G + c; if (L >= nwg) return false;
        int wgid = (int)L; { const int q = nwg / NXCD, r = nwg % NXCD, xcd = wgid % NXCD, off = wgid / NXCD; wgid = (xcd < r ? xcd * (q + 1) : r * (q + 1) + (xcd - r) * q) + off; }
        const int nig = WGM * nN, gid = wgid / nig, fm = gid * WGM, gsz = (nM - fm) < WGM ? (nM - fm) : WGM;
        u.pm = fm + ((wgid % nig) % gsz); u.pn = (wgid % nig) / gsz; return true;
    }
    __device__ __forceinline__ void a_ready(const Unit&) const {}
    __device__ __forceinline__ void done(const Unit&) const {}
};
__device__ __forceinline__ unsigned cvt_pk_bf16(float lo, float hi) { unsigned r; asm volatile("v_cvt_pk_bf16_f32 %0, %1, %2" : "=v"(r) : "v"(lo), "v"(hi)); return r; }
typedef float f32x2 __attribute__((ext_vector_type(2)));
typedef unsigned u32x2 __attribute__((ext_vector_type(2)));
__device__ __forceinline__ float sq4(const f32x4 v) { return (v[0] * v[0] + v[1] * v[1]) + (v[2] * v[2] + v[3] * v[3]); }
template <int CTRL> __device__ __forceinline__ float dpp_ror(float x) { return __int_as_float(__builtin_amdgcn_update_dpp(0, __float_as_int(x), CTRL, 0xf, 0xf, false)); }
struct EpiScaleBf16 {
    static constexpr bool PERM = true, AFTER_DRAIN = false;
    bf16_t* O; int ldc; const float* rs; const float* cw; float* vside; float* wside; float* kss;
    __device__ __forceinline__ void prefetch(const Unit& u, int wr, int fr, float (&rsv)[4]) const {
        const int row0 = u.pm * BM + wr * 64 + fr;
#pragma unroll
        for (int m = 0; m < 4; ++m) rsv[m] = rs ? rs[row0 + m * 16] : 2048.0f;
    }
    __device__ __forceinline__ void operator()(const f32x4 (&acc)[2][2][4][2], const Unit& u, int wr, int wc, int fr, int fq, const float (&rsv)[4]) const {
        if (!cw) {
            const int row0 = u.pm * BM + wr * 64 + fr, col0 = u.pn * BM + wc * 64 + 8 * fq;
            float rs2[4];
#pragma unroll
            for (int m = 0; m < 4; ++m) rs2[m] = rs ? rs[row0 + HALF + m * 16] : 2048.0f;
#pragma unroll
            for (int ai = 0; ai < 2; ++ai)
#pragma unroll
                for (int m = 0; m < 4; ++m) { const int row = row0 + ai * HALF + m * 16;
                    const float sc = rs ? rsqrtf((ai ? rs2[m] : rsv[m]) * (1.0f / 2048.0f) + 1e-6f) : 1.0f;
                    bf16_t* rowp = O + (size_t)row * ldc + col0;
#pragma unroll
                    for (int bj = 0; bj < 2; ++bj) { const f32x4 v0 = acc[ai][bj][m][0] * sc, v1 = acc[ai][bj][m][1] * sc;
                        u32x4 w; w.x = cvt_pk_bf16(v0[0], v0[1]); w.y = cvt_pk_bf16(v0[2], v0[3]); w.z = cvt_pk_bf16(v1[0], v1[1]); w.w = cvt_pk_bf16(v1[2], v1[3]);
                        *(u32x4*)(rowp + bj * 32) = w;
                        if (kss && (u.pn >> 2) == 3) {
                            float ss = sq4(v0) + sq4(v1); ss += __shfl_xor(ss, 16); ss += __shfl_xor(ss, 32);
                            if (fq == 0) atomicAdd(kss + (size_t)row * 8 + 2 * (u.pn - 12) + (wc >> 1), ss); } } }
        } else {
            const int row0 = u.pm * BM + wr * 64 + fr, ch0 = u.pn * 64 + wc * 16 + 4 * fq;
            const f32x4 c0 = *(const f32x4*)(cw + ch0), c1 = *(const f32x4*)(cw + 2048 + ch0), c2 = *(const f32x4*)(cw + 4096 + ch0);
            float rs2[4];
#pragma unroll
            for (int m = 0; m < 4; ++m) rs2[m] = rs[row0 + HALF + m * 16];
#pragma unroll
            for (int ai = 0; ai < 2; ++ai) { f32x4 vprev = {0.f, 0.f, 0.f, 0.f};
                const size_t b64 = (size_t)((u.pm * BM + ai * HALF + wr * 64) >> 6);
#pragma unroll
                for (int m = 0; m < 4; ++m) { const int row = row0 + ai * HALF + m * 16;
                    const float sc = rsqrtf((ai ? rs2[m] : rsv[m]) * (1.0f / 2048.0f) + 1e-6f);
                    const f32x4 Bv = acc[ai][0][m][0] * sc, zv = acc[ai][0][m][1] * sc, Cv = acc[ai][1][m][0] * sc, uv = acc[ai][1][m][1] * sc;
                    const f32x4 v = Cv * uv; f32x4 wv, v1, v2;
#pragma unroll
                    for (int j = 0; j < 4; ++j) { wv[j] = Bv[j] * zv[j] * __builtin_amdgcn_rcpf(1.0f + __expf(-zv[j]));
                        const float a1 = dpp_ror<0x121>(v[j]), p1 = dpp_ror<0x121>(vprev[j]), a2 = dpp_ror<0x122>(v[j]), p2 = dpp_ror<0x122>(vprev[j]);
                        v1[j] = fr >= 1 ? a1 : p1; v2[j] = fr >= 2 ? a2 : p2; }
                    const f32x4 y = wv * (c2 * v + c1 * v1 + c0 * v2);
                    if (m == 0 && fr < 2) { *(f32x4*)(vside + (b64 * 4 + fr) * 2048 + ch0) = v; *(f32x4*)(wside + (b64 * 2 + fr) * 2048 + ch0) = wv; }
                    else { u32x2 w; w.x = cvt_pk_bf16(y[0], y[1]); w.y = cvt_pk_bf16(y[2], y[3]); *(u32x2*)(O + (size_t)row * 2048 + ch0) = w; }
                    if (m == 3 && fr >= 14) *(f32x4*)(vside + (b64 * 4 + 2 + (fr - 14)) * 2048 + ch0) = v;
                    vprev = v; } }
        }
    }
};
__device__ __forceinline__ void unpk8(const u32x4 w, f32x4& lo, f32x4& hi) {
    lo[0] = __uint_as_float(w.x << 16); lo[1] = __uint_as_float(w.x & 0xffff0000u); lo[2] = __uint_as_float(w.y << 16); lo[3] = __uint_as_float(w.y & 0xffff0000u);
    hi[0] = __uint_as_float(w.z << 16); hi[1] = __uint_as_float(w.z & 0xffff0000u); hi[2] = __uint_as_float(w.w << 16); hi[3] = __uint_as_float(w.w & 0xffff0000u); }
__device__ __forceinline__ u32x4 pk8(const f32x4 lo, const f32x4 hi) { u32x4 w; w.x = cvt_pk_bf16(lo[0], lo[1]); w.y = cvt_pk_bf16(lo[2], lo[3]); w.z = cvt_pk_bf16(hi[0], hi[1]); w.w = cvt_pk_bf16(hi[2], hi[3]); return w; }
template <bool F32IN> struct EpiResid {
    static constexpr bool PERM = true, AFTER_DRAIN = false;
    const float* xin32; const bf16_t* xin16; bf16_t* xo; float* rs;
    __device__ __forceinline__ void prefetch(const Unit&, int, int, float (&)[4]) const {}
    typedef f32x4 XBuf[2][2][F32IN ? 2 : 1];
    __device__ __forceinline__ void load2(int c, size_t off0, XBuf& x) const {
#pragma unroll
        for (int g = 0; g < 2; ++g) { const size_t off = off0 + (size_t)((c >> 1) * HALF + (2 * (c & 1) + g) * 16) * 2048;
#pragma unroll
            for (int bj = 0; bj < 2; ++bj) {
                if constexpr (F32IN) { x[g][bj][0] = *(const f32x4*)(xin32 + off + bj * 32); x[g][bj][1] = *(const f32x4*)(xin32 + off + bj * 32 + 4); }
                else x[g][bj][0] = *(const f32x4*)(xin16 + off + bj * 32);     } }
    }
    __device__ __forceinline__ void proc2(const f32x4 (&acc)[2][2][4][2], int c, int row0, size_t off0, int fq, const XBuf& x) const {
        const int ai = c >> 1;
#pragma unroll
        for (int g = 0; g < 2; ++g) { const int m = 2 * (c & 1) + g; const int row = row0 + ai * HALF + m * 16; const size_t off = off0 + (size_t)(ai * HALF + m * 16) * 2048; float s = 0.f;
#pragma unroll
            for (int bj = 0; bj < 2; ++bj) { f32x4 x0, x1;
                if constexpr (F32IN) { x0 = x[g][bj][0]; x1 = x[g][bj][1]; }
                else { const f32x4 r = x[g][bj][0]; u32x4 w; w.x = __float_as_uint(r[0]); w.y = __float_as_uint(r[1]); w.z = __float_as_uint(r[2]); w.w = __float_as_uint(r[3]); unpk8(w, x0, x1); }
                const f32x4 v0 = x0 + acc[ai][bj][m][0], v1 = x1 + acc[ai][bj][m][1];
                s += sq4(v0) + sq4(v1); *(u32x4*)(xo + off + bj * 32) = pk8(v0, v1); }
            s += __shfl_xor(s, 16); s += __shfl_xor(s, 32);
            if (fq == 0) atomicAdd(rs + row, s); }
        asm volatile("" ::: "memory");
    }
    __device__ __forceinline__ void operator()(const f32x4 (&acc)[2][2][4][2], const Unit& u, int wr, int wc, int fr, int fq, const float (&)[4]) const {
        const int row0 = u.pm * BM + wr * 64 + fr, col0 = u.pn * BM + wc * 64 + 8 * fq; const size_t off0 = (size_t)row0 * 2048 + col0;
        XBuf xa, xb;
        load2(0, off0, xa);
        load2(1, off0, xb); proc2(acc, 0, row0, off0, fq, xa);
        load2(2, off0, xa); proc2(acc, 1, row0, off0, fq, xb);
        load2(3, off0, xb); proc2(acc, 2, row0, off0, fq, xa);
        proc2(acc, 3, row0, off0, fq, xb);
    }
};
struct EpiGate {
    static constexpr bool PERM = true, AFTER_DRAIN = false;
    const float* rs_in; const bf16_t* pp; const bf16_t* xin; bf16_t* xo16; float* xo32; float* rs_out;
    __device__ __forceinline__ void prefetch(const Unit& u, int wr, int fr, float (&rsv)[4]) const {
        const int row0 = u.pm * BM + wr * 64 + fr;
#pragma unroll
        for (int m = 0; m < 4; ++m) rsv[m] = rs_in[row0 + m * 16];
    }
    __device__ __forceinline__ void load2(int c, size_t off0, u32x4 (&xw)[2][2], u32x4 (&pw)[2][2]) const {
#pragma unroll
        for (int g = 0; g < 2; ++g) { const size_t off = off0 + (size_t)((c >> 1) * HALF + (2 * (c & 1) + g) * 16) * 2048;
#pragma unroll
            for (int bj = 0; bj < 2; ++bj) { xw[g][bj] = *(const u32x4*)(xin + off + bj * 32); pw[g][bj] = *(const u32x4*)(pp + off + bj * 32); } }
    }
    __device__ __forceinline__ void proc2(const f32x4 (&acc)[2][2][4][2], int c, int row0, size_t off0, int fq, const float (&rsx)[4], const u32x4 (&xw)[2][2], const u32x4 (&pw)[2][2]) const {
        const int ai = c >> 1;
#pragma unroll
        for (int g = 0; g < 2; ++g) { const int m = 2 * (c & 1) + g; const int row = row0 + ai * HALF + m * 16; const size_t off = off0 + (size_t)(ai * HALF + m * 16) * 2048; float s = 0.f;
            const float sc = rsqrtf(rsx[m] * (1.0f / 2048.0f) + 1e-6f);
#pragma unroll
            for (int bj = 0; bj < 2; ++bj) { f32x4 x0, x1, p0, p1; unpk8(xw[g][bj], x0, x1); unpk8(pw[g][bj], p0, p1);
                const f32x4 a0 = acc[ai][bj][m][0] * sc, a1 = acc[ai][bj][m][1] * sc; f32x4 v0, v1;
#pragma unroll
                for (int j = 0; j < 4; ++j) { v0[j] = x0[j] + p0[j] * __builtin_amdgcn_rcpf(1.0f + __expf(-a0[j])); v1[j] = x1[j] + p1[j] * __builtin_amdgcn_rcpf(1.0f + __expf(-a1[j])); }
                if (xo32) { *(f32x4*)(xo32 + off + bj * 32) = v0; *(f32x4*)(xo32 + off + bj * 32 + 4) = v1; }
                else { s += sq4(v0) + sq4(v1); *(u32x4*)(xo16 + off + bj * 32) = pk8(v0, v1); } }
            if (!xo32) { s += __shfl_xor(s, 16); s += __shfl_xor(s, 32); if (fq == 0) atomicAdd(rs_out + row, s); } }
        asm volatile("" ::: "memory");
    }
    __device__ __forceinline__ void operator()(const f32x4 (&acc)[2][2][4][2], const Unit& u, int wr, int wc, int fr, int fq, const float (&rsv)[4]) const {
        const int row0 = u.pm * BM + wr * 64 + fr, col0 = u.pn * BM + wc * 64 + 8 * fq; const size_t off0 = (size_t)row0 * 2048 + col0;
        float rs2[4];
#pragma unroll
        for (int m = 0; m < 4; ++m) rs2[m] = rs_in[row0 + HALF + m * 16];
        u32x4 xa[2][2], pa[2][2], xb[2][2], pb[2][2];
        load2(0, off0, xa, pa);
        load2(1, off0, xb, pb); proc2(acc, 0, row0, off0, fq, rsv, xa, pa);
        load2(2, off0, xa, pa); proc2(acc, 1, row0, off0, fq, rsv, xb, pb);
        load2(3, off0, xb, pb); proc2(acc, 2, row0, off0, fq, rs2, xa, pa);
        proc2(acc, 3, row0, off0, fq, rs2, xb, pb);
    }
};
template <class Epi, class Sched, bool STAMP = false>
__device__ __forceinline__ void gemm_phase(PG8_LAS unsigned char* lds, const Gemm g, const Sched& S, const Epi& E, unsigned long long* stamps) {
    int tid_ = threadIdx.x; asm volatile("" : "+v"(tid_));
    const int tid = tid_, wid = __builtin_amdgcn_readfirstlane(tid >> 6), lane = tid & 63, wr = wid >> 2, wc = wid & 3, fr = lane & 15, fq = lane >> 4;
    const int K = g.K, nt = K / BK;
    int ts_lo = 0, ts_hi = 0, nts = 0; const unsigned long long rt_entry = STAMP ? (unsigned long long)wall_clock64() : 0ull;
#define PG8_STAMP() do { if (STAMP && wid == 0 && nts < 64) { const unsigned long long _c = (unsigned long long)clock64(); \
        ts_lo = (lane == nts) ? (int)(unsigned)_c : ts_lo; ts_hi = (lane == nts) ? (int)(unsigned)(_c >> 32) : ts_hi; ++nts; } } while (0)
    PG8_STAMP();
    unsigned voffA[2], voffB[2];
#pragma unroll
    for (int i = 0; i < 2; ++i) { int R, C; stage_rc(tid * 16 + i * 8192, R, C); const int Rb = Epi::PERM ? ((R & ~31) + perm32(R & 31)) : R;
        voffA[i] = (unsigned)(R * g.ldA + C) * 2u; voffB[i] = (unsigned)(Rb * g.ldB + C) * 2u; }
    const size_t kstep = (size_t)(BK * 2);
    const size_t hstepA = (size_t)HALF * g.ldA * 2, hstepB = (size_t)HALF * g.ldB * 2;
    const size_t tstepA = 2 * hstepA, tstepB = 2 * hstepB;
    const unsigned ldsw = (unsigned)wid * 1024u;
    const int aoff = lds_byte(wr * 64 + fr, fq * 8), boff = lds_byte(wc * 32 + fr, fq * 8);
#define PG8_SA(b, h) (((b) * 2 + (h)) * HTB)
#define PG8_SB(b, h) ((4 + (b) * 2 + (h)) * HTB)
#define PG8_STAGE(bufoff, gbase, voff) do { _Pragma("unroll") for (int _i = 0; _i < 2; ++_i) \
        __builtin_amdgcn_global_load_lds((const unsigned*)((const char*)(gbase) + (voff)[_i]), (PG8_LAS unsigned*)(lds + (bufoff) + ldsw + _i * 8192), 16, 0, 0); } while (0)
#define PG8_LDA(dst, b, h) do { _Pragma("unroll") for (int m = 0; m < 4; ++m) _Pragma("unroll") for (int k = 0; k < 2; ++k) dst[m][k] = *(const PG8_LAS bf16x8*)(lds + PG8_SA(b, h) + aoff + m * 2048 + k * 1024); } while (0)
#define PG8_LDB(dst, b, h) do { _Pragma("unroll") for (int n = 0; n < 2; ++n) _Pragma("unroll") for (int k = 0; k < 2; ++k) dst[n][k] = *(const PG8_LAS bf16x8*)(lds + PG8_SB(b, h) + boff + n * 2048 + k * 1024); } while (0)
#define PG8_MMA(ai, bj, At, Bt) do { __builtin_amdgcn_s_setprio(1); _Pragma("unroll") for (int m = 0; m < 4; ++m) _Pragma("unroll") for (int n = 0; n < 2; ++n) _Pragma("unroll") for (int k = 0; k < 2; ++k) \
        acc[ai][bj][m][n] = __builtin_amdgcn_mfma_f32_16x16x32_bf16(Bt[n][k], At[m][k], acc[ai][bj][m][n], 0, 0, 0); __builtin_amdgcn_s_setprio(0); } while (0)
#define PG8_WAIT_V(n) asm volatile("s_waitcnt vmcnt(" #n ")" ::: "memory")
#define PG8_WAIT_L(n) asm volatile("s_waitcnt lgkmcnt(" #n ")" ::: "memory")
#define PG8_BAR __builtin_amdgcn_s_barrier()
#define PG8_SCHED __builtin_amdgcn_sched_barrier(0)
    Unit cur, nxt; int ui = 0;
    if (!S.next(0, cur)) return;
    f32x4 acc[2][2][4][2];
    float rsv[4];
#pragma unroll
    for (int a = 0; a < 2; ++a)
#pragma unroll
        for (int b = 0; b < 2; ++b)
#pragma unroll
            for (int m = 0; m < 4; ++m)
#pragma unroll
                for (int n = 0; n < 2; ++n) acc[a][b][m][n] = (f32x4){0.f, 0.f, 0.f, 0.f};
    bf16x8 At[4][2], B0[2][2], B1[2][2];
    const char* cA = (const char*)g.A + (size_t)cur.pm * tstepA; const char* cB = (const char*)g.Bt + (size_t)cur.pn * tstepB;
    S.a_ready(cur);
    PG8_STAGE(PG8_SB(0, 0), cB, voffB); PG8_STAGE(PG8_SA(0, 0), cA, voffA); PG8_STAGE(PG8_SB(0, 1), cB + hstepB, voffB); PG8_STAGE(PG8_SA(0, 1), cA + hstepA, voffA);
    if (wr == 1) PG8_BAR;
    PG8_WAIT_V(4); PG8_BAR;
    PG8_STAGE(PG8_SB(1, 0), cB + kstep, voffB); PG8_STAGE(PG8_SA(1, 0), cA + kstep, voffA); PG8_STAGE(PG8_SB(1, 1), cB + hstepB + kstep, voffB);
    PG8_WAIT_V(6); PG8_BAR;
    PG8_STAMP();
    for (;;) {
        const bool has_next = S.next(ui + 1, nxt);
        const char* nA = has_next ? (const char*)g.A + (size_t)nxt.pm * tstepA : cA; const char* nB = has_next ? (const char*)g.Bt + (size_t)nxt.pn * tstepB : cB;
        for (int t = 0; t < nt; t += 2) {
            const bool last = (t == nt - 2);
            const char* a1 = cA + (size_t)(t + 1) * kstep;
            const char* a2 = last ? nA : cA + (size_t)(t + 2) * kstep; const char* b2 = last ? nB : cB + (size_t)(t + 2) * kstep;
            const char* a3 = a2 + kstep; const char* b3 = b2 + kstep;
            if (last && has_next) S.a_ready(nxt);
            if (last) E.prefetch(cur, wr, fr, rsv);
            PG8_LDB(B0, 0, 0); PG8_SCHED; PG8_LDA(At, 0, 0); PG8_STAGE(PG8_SA(1, 1), a1 + hstepA, voffA);
            PG8_WAIT_L(8); PG8_BAR; PG8_WAIT_L(0); PG8_MMA(0, 0, At, B0); PG8_BAR; PG8_SCHED;
            PG8_LDB(B1, 0, 1); PG8_STAGE(PG8_SB(0, 0), b2, voffB);
            PG8_BAR; PG8_WAIT_L(0); PG8_MMA(0, 1, At, B1); PG8_BAR;
            PG8_LDA(At, 0, 1); PG8_STAGE(PG8_SA(0, 0), a2, voffA);
            PG8_BAR; PG8_WAIT_L(0); PG8_MMA(1, 0, At, B0); PG8_BAR; PG8_SCHED;
            PG8_STAGE(PG8_SB(0, 1), b2 + hstepB, voffB);
            PG8_WAIT_V(6); PG8_BAR; PG8_MMA(1, 1, At, B1); PG8_BAR;
            PG8_LDB(B0, 1, 0); PG8_SCHED; PG8_LDA(At, 1, 0); PG8_STAGE(PG8_SA(0, 1), a2 + hstepA, voffA);
            PG8_WAIT_L(8); PG8_BAR; PG8_WAIT_L(0); PG8_MMA(0, 0, At, B0); PG8_BAR; PG8_SCHED;
            PG8_LDB(B1, 1, 1); PG8_STAGE(PG8_SB(1, 0), b3, voffB);
            PG8_BAR; PG8_WAIT_L(0); PG8_MMA(0, 1, At, B1); PG8_BAR;
            PG8_LDA(At, 1, 1); PG8_STAGE(PG8_SA(1, 0), a3, voffA);
            PG8_BAR; PG8_WAIT_L(0); PG8_MMA(1, 0, At, B0); PG8_BAR; PG8_SCHED;
            PG8_STAGE(PG8_SB(1, 1), b3 + hstepB, voffB);
            PG8_WAIT_V(6); PG8_BAR; PG8_MMA(1, 1, At, B1); PG8_BAR;
        }
        PG8_STAMP();
        if constexpr (!Epi::AFTER_DRAIN) { E(acc, cur, wr, wc, fr, fq, rsv); S.done(cur); }
        PG8_STAMP();
        if (!has_next) break;
#pragma unroll
        for (int a = 0; a < 2; ++a)
#pragma unroll
            for (int b = 0; b < 2; ++b)
#pragma unroll
                for (int m = 0; m < 4; ++m)
#pragma unroll
                    for (int n = 0; n < 2; ++n) acc[a][b][m][n] = (f32x4){0.f, 0.f, 0.f, 0.f};
        cur = nxt; cA = nA; cB = nB; ++ui;
    }
    PG8_WAIT_V(0);
    if (wr == 0) PG8_BAR;
    PG8_BAR;
    if constexpr (Epi::AFTER_DRAIN) { E.fused(acc, cur, wr, wc, fr, fq, lds, wid, lane); S.done(cur); }
    PG8_STAMP();
    if (STAMP && wid == 0) { stamps[lane] = lane < nts ? (((unsigned long long)(unsigned)ts_hi << 32) | (unsigned)ts_lo) : 0ull;
        if (lane == 62) stamps[62] = rt_entry; if (lane == 63) stamps[63] = (unsigned long long)wall_clock64(); }
#undef PG8_STAMP
#undef PG8_SA
#undef PG8_SB
#undef PG8_STAGE
#undef PG8_LDA
#undef PG8_LDB
#undef PG8_MMA
#undef PG8_WAIT_V
#undef PG8_WAIT_L
#undef PG8_BAR
#undef PG8_SCHED
}
}
#define LAS __attribute__((address_space(3)))
typedef unsigned short u16;
typedef unsigned int u32;
typedef pg8::bf16x8 bf16x8;
typedef pg8::f32x4 f32x4;
typedef pg8::u32x4 u32x4;
typedef pg8::u32x2 u32x2;
using pg8::cvt_pk_bf16;

constexpr int MROWS = 16384, DM = 2048, SEQ = 4096;
constexpr int NE = 7168, NO = 8192;
constexpr float EPSF = 1e-6f;
constexpr size_t SIDE_OFF = (size_t)64 * 1024 * 1024;
constexpr int LDS_BYTES = 139264 + 16;
#ifndef SCHED_BITS
#define SCHED_BITS 0xA976543210ull
#define SCHED_N 10
#endif

constexpr size_t WS_WT_IN  = 0;
constexpr size_t WS_WT_O0  = WS_WT_IN + (size_t)8192 * 2048 * 2;
constexpr size_t WS_WT_O1  = WS_WT_O0 + (size_t)2048 * 2048 * 2;
constexpr size_t WS_WT_G0  = WS_WT_O1 + (size_t)2048 * 2048 * 2;
constexpr size_t WS_WT_G1  = WS_WT_G0 + (size_t)2048 * 2048 * 2;
constexpr size_t WS_WT_P0  = WS_WT_G1 + (size_t)2048 * 2048 * 2;
constexpr size_t WS_WT_P1  = WS_WT_P0 + (size_t)2048 * 256 * 2;
constexpr size_t WS_PROJ   = WS_WT_P1 + (size_t)2048 * 256 * 2;
constexpr size_t WS_XA     = WS_PROJ + (size_t)16384 * 8192 * 2;
constexpr size_t WS_XB     = WS_XA + (size_t)16384 * 2048 * 2;
constexpr size_t WS_PBF    = WS_XB + (size_t)16384 * 2048 * 2;
constexpr size_t WS_RS     = WS_PBF + (size_t)2 * 16384 * 256 * 2;
constexpr size_t WS_LSE    = WS_RS + (size_t)4 * 16384 * 4;
constexpr size_t WS_BAR    = WS_LSE + (size_t)3 * 16384 * 8 * 4;
constexpr size_t WS_KSS    = WS_BAR + 16384;
constexpr size_t WS_END    = WS_KSS + (size_t)16384 * 8 * 4;

#ifndef EN_P0
#define EN_P0 1
#endif
#ifndef EN_P2
#define EN_P2 1
#endif
#ifndef EN_P3
#define EN_P3 1
#endif
#ifndef EN_P4
#define EN_P4 1
#endif
#ifndef EN_P8
#define EN_P8 1
#endif
#ifndef EN_GR
#define EN_GR 1
#endif
#ifndef EN_GS
#define EN_GS 1
#endif
#ifndef EN_GG
#define EN_GG 1
#endif
struct Params { const float* in[14]; float* out; unsigned char* ws; unsigned long long sched; int nsched, pad_; };

__device__ __forceinline__ float bflo(u32 w) { return __uint_as_float(w << 16); }
__device__ __forceinline__ float bfhi(u32 w) { return __uint_as_float(w & 0xffff0000u); }
__device__ __forceinline__ void unpack8(const u32x4 w, float (&f)[8]) { f[0] = bflo(w.x); f[1] = bfhi(w.x); f[2] = bflo(w.y); f[3] = bfhi(w.y); f[4] = bflo(w.z); f[5] = bfhi(w.z); f[6] = bflo(w.w); f[7] = bfhi(w.w); }
__device__ __forceinline__ u32x4 pack8(const float (&f)[8]) { u32x4 w; w.x = cvt_pk_bf16(f[0], f[1]); w.y = cvt_pk_bf16(f[2], f[3]); w.z = cvt_pk_bf16(f[4], f[5]); w.w = cvt_pk_bf16(f[6], f[7]); return w; }
template <int CTRL> __device__ __forceinline__ float dppf(float x) { return __int_as_float(__builtin_amdgcn_update_dpp(0, __float_as_int(x), CTRL, 0xf, 0xf, true)); }
__device__ __forceinline__ float row16_sum(float s) { s += dppf<0xB1>(s); s += dppf<0x4E>(s); s += dppf<0x124>(s); s += dppf<0x128>(s); return s; }
__device__ __forceinline__ float silu_f(float z) { return z * __builtin_amdgcn_rcpf(1.0f + __expf(-z)); }
__device__ __forceinline__ f32x4 mfma16(bf16x8 a, bf16x8 b, f32x4 c) { return __builtin_amdgcn_mfma_f32_16x16x32_bf16(a, b, c, 0, 0, 0); }

struct TJob { const float* W; u16* WT; const float* gk; int K, N, item, perm; };
__device__ __forceinline__ void t_load(const TJob& j, int tid, f32x4 (&v)[2], float (&gv)[2]) {
    const int nblk = j.N >> 6, kb = j.item / nblk, nb = j.item - kb * nblk, k0 = kb << 6, n0 = nb << 6, ty = tid >> 4, tx = tid & 15;
#pragma unroll
    for (int i = 0; i < 2; ++i) { const int kk = ty + 32 * i; v[i] = __builtin_nontemporal_load((const f32x4*)(j.W + (size_t)(k0 + kk) * j.N + n0 + 4 * tx)); gv[i] = j.gk ? j.gk[k0 + kk] : 1.0f; }
}
template <class Dec>
__device__ __forceinline__ void transpose_run(const Dec& dec, int nitems, LAS float* scr, int bid, int G, int tid) {
    asm volatile("" : "+v"(tid));
    if (bid >= nitems) return;
    f32x4 v[2]; float gv[2];
    { const TJob j0 = dec(bid); t_load(j0, tid, v, gv); }
    const int ty = tid >> 4, tx = tid & 15, n = tid >> 3, c = tid & 7;
    for (int it = bid; it < nitems; it += G) {
        const TJob j = dec(it);
#pragma unroll
        for (int i = 0; i < 2; ++i) { const int kk = ty + 32 * i; const f32x4 t = v[i] * gv[i];
            scr[kk * 65 + 4 * tx + 0] = t[0]; scr[kk * 65 + 4 * tx + 1] = t[1]; scr[kk * 65 + 4 * tx + 2] = t[2]; scr[kk * 65 + 4 * tx + 3] = t[3]; }
        __syncthreads();
        { const int nx = (it + G < nitems) ? it + G : it; const TJob jn = dec(nx); t_load(jn, tid, v, gv); }
        const int nblk = j.N >> 6, kb = j.item / nblk, nb = j.item - kb * nblk, k0 = kb << 6, n0 = nb << 6;
        const LAS float* s = scr + (8 * c) * 65 + n;
        u32x4 o; o.x = cvt_pk_bf16(s[0], s[65]); o.y = cvt_pk_bf16(s[2 * 65], s[3 * 65]); o.z = cvt_pk_bf16(s[4 * 65], s[5 * 65]); o.w = cvt_pk_bf16(s[6 * 65], s[7 * 65]);
        int orow = n0 + n;
        if (j.perm == 1) { const int part = orow >> 11, ch = orow & 2047; orow = 256 * (ch >> 6) + 128 * ((part == 1 || part == 2) ? 1 : 0) + 32 * ((ch >> 4) & 3) + 8 * ((ch >> 2) & 3) + (ch & 3) + ((part >= 2) ? 4 : 0); }
        else if (j.perm == 2) { const int c = orow & 255; orow = (orow & ~255) + 128 * ((c >> 5) & 1) + 32 * (c >> 6) + 8 * ((c >> 3) & 3) + (c & 7); }
        *(u32x4*)(j.WT + (size_t)orow * j.K + k0 + 8 * c) = o;
        __syncthreads();
    }
}

__device__ __forceinline__ void t_load_big(const TJob& j, int tid, f32x4 (&v)[8], float (&gv)[8]) {
    const int nblk = j.N >> 8, kb = j.item / nblk, nb = j.item - kb * nblk, k0 = kb << 6, n0 = nb << 8, ty = tid >> 6, tx = tid & 63;
#pragma unroll
    for (int i = 0; i < 8; ++i) { const int kk = ty + 8 * i; v[i] = __builtin_nontemporal_load((const f32x4*)(j.W + (size_t)(k0 + kk) * j.N + n0 + 4 * tx)); gv[i] = j.gk ? j.gk[k0 + kk] : 1.0f; }
}
template <class Dec>
__device__ __forceinline__ void transpose_run_big(const Dec& dec, int nitems, LAS float* scr, int bid, int G, int tid) {
    asm volatile("" : "+v"(tid));
    if (bid >= nitems) return;
    f32x4 v[8]; float gv[8];
    { const TJob j0 = dec(bid); t_load_big(j0, tid, v, gv); }
    const int ty = tid >> 6, tx = tid & 63;
    for (int it = bid; it < nitems; it += G) {
        const TJob j = dec(it);
#pragma unroll
        for (int i = 0; i < 8; ++i) { const int kk = ty + 8 * i; const f32x4 t = v[i] * gv[i];
            scr[kk * 257 + 4 * tx + 0] = t[0]; scr[kk * 257 + 4 * tx + 1] = t[1]; scr[kk * 257 + 4 * tx + 2] = t[2]; scr[kk * 257 + 4 * tx + 3] = t[3]; }
        __syncthreads();
        { const int nx = (it + G < nitems) ? it + G : it; const TJob jn = dec(nx); t_load_big(jn, tid, v, gv); }
        const int nblk = j.N >> 8, kb = j.item / nblk, nb = j.item - kb * nblk, k0 = kb << 6, n0 = nb << 8;
#pragma unroll
        for (int i = 0; i < 4; ++i) { const int q = tid + 512 * i, n = q >> 3, c = q & 7; const LAS float* s = scr + (8 * c) * 257 + n;
            u32x4 o; o.x = cvt_pk_bf16(s[0], s[257]); o.y = cvt_pk_bf16(s[2 * 257], s[3 * 257]); o.z = cvt_pk_bf16(s[4 * 257], s[5 * 257]); o.w = cvt_pk_bf16(s[6 * 257], s[7 * 257]);
            int orow = n0 + n;
            if (j.perm == 1) { const int part = orow >> 11, ch = orow & 2047; orow = 256 * (ch >> 6) + 128 * ((part == 1 || part == 2) ? 1 : 0) + 32 * ((ch >> 4) & 3) + 8 * ((ch >> 2) & 3) + (ch & 3) + ((part >= 2) ? 4 : 0); }
            else if (j.perm == 2) { const int cc = orow & 255; orow = (orow & ~255) + 128 * ((cc >> 5) & 1) + 32 * (cc >> 6) + 8 * ((cc >> 3) & 3) + (cc & 7); }
            *(u32x4*)(j.WT + (size_t)orow * j.K + k0 + 8 * c) = o; }
        __syncthreads();
    }
}

typedef unsigned short u16x4 __attribute__((ext_vector_type(4)));
__device__ __forceinline__ unsigned off_b(unsigned row, unsigned ch) { return 256u * row + 16u * (ch ^ (((row & 3u) << 2) | ((row >> 2) & 3u))); }
__device__ __forceinline__ u16x4 tr_issue(unsigned addr) { u16x4 r; asm volatile("ds_read_b64_tr_b16 %0, %1" : "=&v"(r) : "v"(addr) : "memory"); return r; }
__device__ __forceinline__ bf16x8 tr_join(const u16x4 a, const u16x4 b) { bf16x8 v; v[0] = (short)a[0]; v[1] = (short)a[1]; v[2] = (short)a[2]; v[3] = (short)a[3]; v[4] = (short)b[0]; v[5] = (short)b[1]; v[6] = (short)b[2]; v[7] = (short)b[3]; return v; }
__device__ __forceinline__ unsigned tr_addr(unsigned base, int lane, int ks, int c, int t) {
    const unsigned g = (unsigned)lane >> 4, q4 = ((unsigned)lane & 15u) >> 2, p4 = (unsigned)lane & 3u;
    return base + off_b(32u * ks + 8u * g + 4u * t + q4, 2u * c + (p4 >> 1)) + 8u * (p4 & 1u);
}

struct ARun { int g, b, h, dil, r, n0, len; };
__device__ __forceinline__ ARun attn_run(int rho) {
    ARun R; int bh;
    if (rho < 256) { R.g = 0; R.dil = 1; bh = rho >> 3; R.r = 0; R.n0 = (rho & 7) * 4; R.len = 4; }
    else if (rho < 512) { const int q = rho - 256, tri = q >> 1; R.g = 1; R.dil = 4; bh = tri >> 2; R.r = tri & 3; R.n0 = (q & 1) * 4; R.len = 4; }
    else { const int q = rho - 512; R.g = 2; R.dil = 16; bh = q >> 4; R.r = q & 15; R.n0 = 0; R.len = 2; }
    R.b = bh >> 3; R.h = bh & 7; return R;
}
__device__ __forceinline__ void attn_load_half(const u16* __restrict__ proj, const float* __restrict__ kss, const ARun& R, int k, int tid, u32x4 (&kw)[4], u32x4 (&vw)[4], float& ksr) {
    const int sb = (R.n0 + k - 1) * 128;
    const u16* kbase = proj + (size_t)R.b * SEQ * NE + 3072 + R.h * 128 + (tid & 15) * 8;
#pragma unroll
    for (int i = 0; i < 4; ++i) { int sidx = sb + (tid >> 4) + 32 * i; if (sidx < 0) sidx = 0;
        const size_t t = (size_t)R.r + (size_t)sidx * R.dil;
        kw[i] = *(const u32x4*)(kbase + t * NE); vw[i] = *(const u32x4*)(kbase + t * NE + 1024); }
    { int sidx = sb + (tid & 127); if (sidx < 0) sidx = 0; ksr = kss[((size_t)R.b * SEQ + (size_t)R.r + (size_t)sidx * R.dil) * 8 + R.h]; }
}
__device__ __forceinline__ void attn_load_q(const u16* __restrict__ proj, const ARun& R, int i, int wid, int lane, u32x4 (&qw)[4]) {
    const size_t tq = (size_t)R.r + (size_t)((R.n0 + i) * 128 + 16 * wid + (lane & 15)) * R.dil; const u16* qp = proj + ((size_t)R.b * SEQ + tq) * NE + 2048 + R.h * 128 + 8 * (lane >> 4);
#pragma unroll
    for (int ks = 0; ks < 4; ++ks) qw[ks] = *(const u32x4*)(qp + 32 * ks);
}
__device__ __forceinline__ void attn_item(LAS unsigned char* lds, const u16* __restrict__ proj, u16* __restrict__ og, float* __restrict__ lse, const float* __restrict__ kss,
                                          const float (&qgv)[4][8], const ARun& R, int i, const ARun& Rn, int in, bool nfirst,
                                          u32x4 (&kw0)[4], u32x4 (&vw0)[4], float& ks0, u32x4 (&kw1)[4], u32x4 (&vw1)[4], float& ks1, u32x4 (&qw)[4], int tid, int wid, int lane) {
    asm volatile("" : "+v"(lane), "+v"(tid));
    const int fr = lane & 15, fq = lane >> 4;
    const int g = R.g, h = R.h, dil = R.dil, r = R.r, n = R.n0 + i, par = i & 1;
    const bool first = (i == 0);
    const float slope = exp2f(-(float)(h + 1));
    const size_t rowbase = (size_t)R.b * SEQ;
    LAS unsigned char* Ks = lds;
    LAS unsigned char* Vs = lds + 69632;
    LAS float* rkL = (LAS float*)(lds + 135168);
    __syncthreads();
    {
        const int pc = tid & 15;
        const int slot0 = first ? 0 : ((i + 1) & 1);
#pragma unroll
        for (int q = 0; q < 4; ++q) { const int row = 128 * slot0 + (tid >> 4) + 32 * q;
            *(LAS u32x4*)(Ks + row * 272 + pc * 16) = kw0[q]; *(LAS u32x4*)(Vs + off_b((unsigned)row, (unsigned)pc)) = vw0[q]; }
        if (tid < 128) rkL[128 * slot0 + tid] = rsqrtf(ks0 * (1.0f / 128.0f) + EPSF);
        if (first) {
#pragma unroll
            for (int q = 0; q < 4; ++q) { const int row = 128 + (tid >> 4) + 32 * q;
                *(LAS u32x4*)(Ks + row * 272 + pc * 16) = kw1[q]; *(LAS u32x4*)(Vs + off_b((unsigned)row, (unsigned)pc)) = vw1[q]; }
            if (tid < 128) rkL[128 + tid] = rsqrtf(ks1 * (1.0f / 128.0f) + EPSF);
        }
    }
    const int qi = 16 * wid + fr;
    const size_t tq = (size_t)r + (size_t)(n * 128 + qi) * dil;
    bf16x8 qf[4];
    {
        float qv[4][8]; float ss = 0.f;
#pragma unroll
        for (int ks = 0; ks < 4; ++ks) { unpack8(qw[ks], qv[ks]);
#pragma unroll
            for (int j = 0; j < 8; ++j) ss += qv[ks][j] * qv[ks][j]; }
        ss += __shfl_xor(ss, 16); ss += __shfl_xor(ss, 32);
        const float qs = rsqrtf(ss * (1.0f / 128.0f) + EPSF) * (0.08838834764831845f * 1.4426950408889634f);
#pragma unroll
        for (int ks = 0; ks < 4; ++ks) { float t[8];
#pragma unroll
            for (int j = 0; j < 8; ++j) t[j] = qv[ks][j] * qs * qgv[ks][j];
            qf[ks] = __builtin_bit_cast(bf16x8, pack8(t)); }
    }
    __syncthreads();
    const int kt0 = 2 * (wid >> 1);
    const int px = par << 7;
    f32x4 s[10];
#pragma unroll
    for (int j = 0; j < 10; ++j) { f32x4 acc = {0.f, 0.f, 0.f, 0.f};
#pragma unroll
        for (int ks = 0; ks < 4; ++ks) { const bf16x8 kf = *(const LAS bf16x8*)(Ks + ((16 * (kt0 + j) + fr) ^ px) * 272 + (32 * ks + 8 * fq) * 2); acc = mfma16(kf, qf[ks], acc); }
        s[j] = acc; __builtin_amdgcn_sched_barrier(0); }
    const float sl2 = slope * (float)dil * 1.4426950408889634f;
    const int C0 = qi - 16 * kt0 - 4 * fq + 128;
    int LO = C0 - 128; if (n == 0) LO = max(LO, 128 - 16 * kt0 - 4 * fq);
    const unsigned range = (unsigned)(C0 - LO);
    const float b0 = -sl2 * (float)C0;
    f32x4 rk[10];
#pragma unroll
    for (int j = 0; j < 10; ++j) rk[j] = *(const LAS f32x4*)(rkL + ((16 * (kt0 + j) + 4 * fq) ^ px));
    float mx = -3.0e38f;
#pragma unroll
    for (int j = 0; j < 10; ++j)
#pragma unroll
        for (int ii = 0; ii < 4; ++ii) { const int cji = 16 * j + ii;
            const float v0 = fmaf(sl2, (float)cji, fmaf(s[j][ii], rk[j][ii], b0));
            const float v = ((unsigned)(cji - LO) <= range) ? v0 : -1.0e30f; s[j][ii] = v; mx = fmaxf(mx, v); }
    mx = fmaxf(mx, __shfl_xor(mx, 16)); mx = fmaxf(mx, __shfl_xor(mx, 32));
    float l = 0.f;
#pragma unroll
    for (int j = 0; j < 10; ++j)
#pragma unroll
        for (int ii = 0; ii < 4; ++ii) { const float p = __builtin_amdgcn_exp2f(s[j][ii] - mx); s[j][ii] = p; l += p; }
    l += __shfl_xor(l, 16); l += __shfl_xor(l, 32);
    bf16x8 pf[5];
#pragma unroll
    for (int k5 = 0; k5 < 5; ++k5) { u32x4 w; w.x = cvt_pk_bf16(s[2 * k5][0], s[2 * k5][1]); w.y = cvt_pk_bf16(s[2 * k5][2], s[2 * k5][3]);
        w.z = cvt_pk_bf16(s[2 * k5 + 1][0], s[2 * k5 + 1][1]); w.w = cvt_pk_bf16(s[2 * k5 + 1][2], s[2 * k5 + 1][3]); pf[k5] = __builtin_bit_cast(bf16x8, w); }
    attn_load_half(proj, kss, Rn, nfirst ? 0 : in + 1, tid, kw0, vw0, ks0);
    if (nfirst) attn_load_half(proj, kss, Rn, 1, tid, kw1, vw1, ks1);
    attn_load_q(proj, Rn, in, wid, lane, qw);
    f32x4 o[8];
#pragma unroll
    for (int dt = 0; dt < 8; ++dt) o[dt] = (f32x4){0.f, 0.f, 0.f, 0.f};
    {
        unsigned va_addr[8][2];
        { const unsigned q4 = ((unsigned)lane & 15u) >> 2, p4 = (unsigned)lane & 3u;
#pragma unroll
          for (int t = 0; t < 2; ++t)
#pragma unroll
            for (int dt = 0; dt < 8; ++dt) va_addr[dt][t] = (unsigned)(size_t)Vs + off_b(16u * t + 4u * fq + q4, 2u * dt + (p4 >> 1)) + 8u * (p4 & 1u); }
#pragma unroll
        for (int k5 = 0; k5 < 5; ++k5) { const unsigned koff = 8192u * (unsigned)(((wid >> 1) + k5) ^ (par << 2)); u16x4 va[8][2];
#pragma unroll
            for (int t = 0; t < 2; ++t)
#pragma unroll
                for (int dt = 0; dt < 8; ++dt) va[dt][t] = tr_issue(va_addr[dt][t] + koff);
            asm volatile("s_waitcnt lgkmcnt(0)" : "+v"(va[0][0]), "+v"(va[0][1]), "+v"(va[1][0]), "+v"(va[1][1]), "+v"(va[2][0]), "+v"(va[2][1]), "+v"(va[3][0]), "+v"(va[3][1]),
                                                   "+v"(va[4][0]), "+v"(va[4][1]), "+v"(va[5][0]), "+v"(va[5][1]), "+v"(va[6][0]), "+v"(va[6][1]), "+v"(va[7][0]), "+v"(va[7][1]) :: "memory");
#pragma unroll
            for (int dt = 0; dt < 8; ++dt) o[dt] = mfma16(tr_join(va[dt][0], va[dt][1]), pf[k5], o[dt]);
            __builtin_amdgcn_sched_barrier(0); }
    }
    const float inv = __builtin_amdgcn_rcpf(l);
    const size_t orow = (size_t)g * MROWS + rowbase + tq;
    u16* op = og + orow * 1024 + h * 128 + 4 * fq;
#pragma unroll
    for (int dt = 0; dt < 8; ++dt) { u32x2 w; w.x = cvt_pk_bf16(o[dt][0] * inv, o[dt][1] * inv); w.y = cvt_pk_bf16(o[dt][2] * inv, o[dt][3] * inv); *(u32x2*)(op + 16 * dt) = w; }
    if (fq == 0) lse[orow * 8 + h] = (mx + __builtin_amdgcn_logf(l)) * 0.6931471805599453f;
}

__device__ __forceinline__ float ret_log_g(int h) { return __logf(1.0f - exp2f(-5.0f - (float)h)); }

__device__ __forceinline__ void ret_contrib_item(LAS unsigned char* lds, const u16* __restrict__ proj, float* __restrict__ ST, int item, int tid, int wid, int lane) {
    asm volatile("" : "+v"(lane), "+v"(tid));
    const int fr = lane & 15, fq = lane >> 4;
    const int bh = item >> 5, n = item & 31, b = bh >> 2, h = bh & 3;
    const size_t row0 = (size_t)b * SEQ + (size_t)n * 128;
    const u16* kbase = proj + row0 * NE + 512 + h * 128;
    const u16* vbase = proj + row0 * NE + 1024 + h * 256;
    const float lg = ret_log_g(h);
    LAS unsigned char* Ks = lds;
    LAS unsigned char* Vs = lds + 32768;
    u32x4 kw[4], vw[8];
#pragma unroll
    for (int i = 0; i < 4; ++i) { const int p = tid + 512 * i; kw[i] = *(const u32x4*)(kbase + (size_t)(p >> 4) * NE + (p & 15) * 8); }
#pragma unroll
    for (int i = 0; i < 8; ++i) { const int p = tid + 512 * i; vw[i] = *(const u32x4*)(vbase + (size_t)(p >> 5) * NE + (p & 31) * 8); }
    __syncthreads();
#pragma unroll
    for (int i = 0; i < 4; ++i) { const int p = tid + 512 * i, sI = p >> 4, pc = p & 15;
        const float zs = __expf(lg * (float)(127 - sI)) * 0.08838834764831845f;
        float f[8]; unpack8(kw[i], f);
#pragma unroll
        for (int j = 0; j < 8; ++j) f[j] *= zs;
        *(LAS u32x4*)(Ks + off_b((unsigned)sI, (unsigned)pc)) = pack8(f); }
#pragma unroll
    for (int i = 0; i < 8; ++i) { const int p = tid + 512 * i, sI = p >> 5, pc = p & 31;
        *(LAS u32x4*)(Vs + (pc >> 4) * 32768 + off_b((unsigned)sI, (unsigned)(pc & 15))) = vw[i]; }
    __syncthreads();
    f32x4 acc[2][8];
#pragma unroll
    for (int mt = 0; mt < 2; ++mt)
#pragma unroll
        for (int nt = 0; nt < 8; ++nt) acc[mt][nt] = (f32x4){0.f, 0.f, 0.f, 0.f};
    const unsigned kb = (unsigned)(size_t)Ks, vb = (unsigned)(size_t)Vs + (unsigned)(wid >> 2) * 32768u;
#pragma unroll
    for (int ks = 0; ks < 4; ++ks) {
        u16x4 ka[8][2], va[2][2];
#pragma unroll
        for (int t = 0; t < 2; ++t) {
#pragma unroll
            for (int nt = 0; nt < 8; ++nt) ka[nt][t] = tr_issue(tr_addr(kb, lane, ks, nt, t));
#pragma unroll
            for (int mt = 0; mt < 2; ++mt) va[mt][t] = tr_issue(tr_addr(vb, lane, ks, 2 * (wid & 3) + mt, t)); }
        asm volatile("s_waitcnt lgkmcnt(0)" : "+v"(ka[0][0]), "+v"(ka[0][1]), "+v"(ka[1][0]), "+v"(ka[1][1]), "+v"(ka[2][0]), "+v"(ka[2][1]), "+v"(ka[3][0]), "+v"(ka[3][1]),
                                               "+v"(ka[4][0]), "+v"(ka[4][1]), "+v"(ka[5][0]), "+v"(ka[5][1]), "+v"(ka[6][0]), "+v"(ka[6][1]), "+v"(ka[7][0]), "+v"(ka[7][1]),
                                               "+v"(va[0][0]), "+v"(va[0][1]), "+v"(va[1][0]), "+v"(va[1][1]) :: "memory");
        const bf16x8 vf0 = tr_join(va[0][0], va[0][1]), vf1 = tr_join(va[1][0], va[1][1]);
#pragma unroll
        for (int nt = 0; nt < 8; ++nt) { const bf16x8 kf = tr_join(ka[nt][0], ka[nt][1]); acc[0][nt] = mfma16(kf, vf0, acc[0][nt]); acc[1][nt] = mfma16(kf, vf1, acc[1][nt]); }
        __builtin_amdgcn_sched_barrier(0); }
    float* out = ST + (size_t)item * 32768;
#pragma unroll
    for (int mt = 0; mt < 2; ++mt)
#pragma unroll
        for (int nt = 0; nt < 8; ++nt) *(f32x4*)(out + (32 * wid + 16 * mt + fr) * 128 + 16 * nt + 4 * fq) = acc[mt][nt];
}

__device__ __forceinline__ void ret_out_item(LAS unsigned char* lds, const u16* __restrict__ proj, const u16* __restrict__ RT, const float* __restrict__ gn, u16* __restrict__ y0,
                                             int item, int tid, int wid, int lane) {
    asm volatile("" : "+v"(lane), "+v"(tid));
    const int fr = lane & 15, fq = lane >> 4;
    const int bh = item >> 5, n = item & 31, b = bh >> 2, h = bh & 3;
    const size_t row0 = (size_t)b * SEQ + (size_t)n * 128;
    const u16* qbase = proj + row0 * NE + h * 128;
    const u16* kbase = proj + row0 * NE + 512 + h * 128;
    const u16* vbase = proj + row0 * NE + 1024 + h * 256;
    const u16* zbase = proj + row0 * NE + 5120 + h * 256;
    const u16* rtb = RT + (size_t)item * 32768;
    const float lg = ret_log_g(h);
    LAS unsigned char* Ks = lds;
    LAS unsigned char* Ps = lds + 34816;
    LAS unsigned char* Vh = lds + 69632;
    LAS unsigned char* Rh = lds + 102400;
    u32x4 kw[4], vw[4], rw[4];
#pragma unroll
    for (int i = 0; i < 4; ++i) { const int p = tid + 512 * i, sI = p >> 4, pc = p & 15;
        kw[i] = *(const u32x4*)(kbase + (size_t)sI * NE + pc * 8); vw[i] = *(const u32x4*)(vbase + (size_t)sI * NE + pc * 8); rw[i] = *(const u32x4*)(rtb + (size_t)sI * 128 + pc * 8); }
    const int c = 16 * wid + fr;
    bf16x8 qf[4], qx[4];
    {
        const u16* qp = qbase + (size_t)c * NE; const float xi = __expf(lg * (float)(c + 1));
#pragma unroll
        for (int ks = 0; ks < 4; ++ks) { const u32x4 w = *(const u32x4*)(qp + 32 * ks + 8 * fq); qf[ks] = __builtin_bit_cast(bf16x8, w);
            float f[8]; unpack8(w, f);
#pragma unroll
            for (int j = 0; j < 8; ++j) f[j] *= xi;
            qx[ks] = __builtin_bit_cast(bf16x8, pack8(f)); }
    }
    __syncthreads();
#pragma unroll
    for (int i = 0; i < 4; ++i) { const int p = tid + 512 * i, sI = p >> 4, pc = p & 15;
        *(LAS u32x4*)(Ks + sI * 272 + pc * 16) = kw[i]; *(LAS u32x4*)(Vh + off_b((unsigned)sI, (unsigned)pc)) = vw[i]; *(LAS u32x4*)(Rh + sI * 272 + pc * 16) = rw[i]; }
#pragma unroll
    for (int i = 0; i < 4; ++i) { const int p = tid + 512 * i, sI = p >> 4, pc = p & 15;
        vw[i] = *(const u32x4*)(vbase + (size_t)sI * NE + 128 + pc * 8); rw[i] = *(const u32x4*)(rtb + (size_t)(128 + sI) * 128 + pc * 8); }
    __syncthreads();
#pragma unroll
    for (int st = 0; st < 8; ++st) {
        u32x2 w; w.x = 0u; w.y = 0u;
        if (st <= wid) { f32x4 acc = {0.f, 0.f, 0.f, 0.f};
#pragma unroll
            for (int ks = 0; ks < 4; ++ks) { const bf16x8 kf = *(const LAS bf16x8*)(Ks + (16 * st + fr) * 272 + (32 * ks + 8 * fq) * 2); acc = mfma16(kf, qf[ks], acc); }
            float pv[4];
#pragma unroll
            for (int i = 0; i < 4; ++i) { const int d = c - (16 * st + 4 * fq + i); pv[i] = (d >= 0) ? acc[i] * 0.08838834764831845f * __expf(lg * (float)d) : 0.f; }
            w.x = cvt_pk_bf16(pv[0], pv[1]); w.y = cvt_pk_bf16(pv[2], pv[3]); }
        *(LAS u32x2*)(Ps + c * 272 + (16 * st + 4 * fq) * 2) = w; __builtin_amdgcn_sched_barrier(0);
    }
    f32x4 y[2][8];
#pragma unroll
    for (int hf = 0; hf < 2; ++hf)
#pragma unroll
        for (int vt = 0; vt < 8; ++vt) y[hf][vt] = (f32x4){0.f, 0.f, 0.f, 0.f};
    const unsigned vhb = (unsigned)(size_t)Vh;
#pragma unroll
    for (int hf = 0; hf < 2; ++hf) {
        if (hf == 1) {
            __syncthreads();
#pragma unroll
            for (int i = 0; i < 4; ++i) { const int p = tid + 512 * i, sI = p >> 4, pc = p & 15;
                *(LAS u32x4*)(Vh + off_b((unsigned)sI, (unsigned)pc)) = vw[i]; *(LAS u32x4*)(Rh + sI * 272 + pc * 16) = rw[i]; }
            __syncthreads();
        }
#pragma unroll
        for (int ks = 0; ks < 4; ++ks) { const bf16x8 pf = *(const LAS bf16x8*)(Ps + c * 272 + (32 * ks + 8 * fq) * 2);
            u16x4 va[8][2];
#pragma unroll
            for (int t = 0; t < 2; ++t)
#pragma unroll
                for (int vt = 0; vt < 8; ++vt) va[vt][t] = tr_issue(tr_addr(vhb, lane, ks, vt, t));
            asm volatile("s_waitcnt lgkmcnt(0)" : "+v"(va[0][0]), "+v"(va[0][1]), "+v"(va[1][0]), "+v"(va[1][1]), "+v"(va[2][0]), "+v"(va[2][1]), "+v"(va[3][0]), "+v"(va[3][1]),
                                                   "+v"(va[4][0]), "+v"(va[4][1]), "+v"(va[5][0]), "+v"(va[5][1]), "+v"(va[6][0]), "+v"(va[6][1]), "+v"(va[7][0]), "+v"(va[7][1]) :: "memory");
#pragma unroll
            for (int vt = 0; vt < 8; ++vt) y[hf][vt] = mfma16(tr_join(va[vt][0], va[vt][1]), pf, y[hf][vt]);
            __builtin_amdgcn_sched_barrier(0); }
#pragma unroll
        for (int ks = 0; ks < 4; ++ks) {
#pragma unroll
            for (int vt = 0; vt < 8; ++vt) { const bf16x8 rf = *(const LAS bf16x8*)(Rh + (16 * vt + fr) * 272 + (32 * ks + 8 * fq) * 2); y[hf][vt] = mfma16(rf, qx[ks], y[hf][vt]); } __builtin_amdgcn_sched_barrier(0); }
#pragma unroll
        for (int vt = 0; vt < 8; ++vt) asm volatile("" : "+v"(y[hf][vt]));
    }
    float sum = 0.f;
#pragma unroll
    for (int hf = 0; hf < 2; ++hf)
#pragma unroll
        for (int vt = 0; vt < 8; ++vt) sum += (y[hf][vt][0] + y[hf][vt][1]) + (y[hf][vt][2] + y[hf][vt][3]);
    sum += __shfl_xor(sum, 16); sum += __shfl_xor(sum, 32);
    const float mu = sum * (1.0f / 256.0f);
    float var = 0.f;
#pragma unroll
    for (int hf = 0; hf < 2; ++hf)
#pragma unroll
        for (int vt = 0; vt < 8; ++vt) { const f32x4 d = y[hf][vt] - mu; var += (d[0] * d[0] + d[1] * d[1]) + (d[2] * d[2] + d[3] * d[3]); }
    var += __shfl_xor(var, 16); var += __shfl_xor(var, 32);
    const float rstd = rsqrtf(var * (1.0f / 256.0f) + EPSF);
    const u16* zp = zbase + (size_t)c * NE;
    u16* yp = y0 + (row0 + c) * DM + h * 256;
#pragma unroll
    for (int hf = 0; hf < 2; ++hf)
#pragma unroll
        for (int vt = 0; vt < 8; ++vt) { const int v = 128 * hf + 16 * vt + 4 * fq;
            const f32x4 gv = *(const f32x4*)(gn + h * 256 + v); const u32x2 zw = *(const u32x2*)(zp + v);
            const float z0 = bflo(zw.x), z1 = bfhi(zw.x), z2 = bflo(zw.y), z3 = bfhi(zw.y);
            const f32x4 t = (y[hf][vt] - mu) * rstd * gv;
            u32x2 w; w.x = cvt_pk_bf16(t[0] * silu_f(z0), t[1] * silu_f(z1)); w.y = cvt_pk_bf16(t[2] * silu_f(z2), t[3] * silu_f(z3));
            *(u32x2*)(yp + v) = w; }
}

#define XB_TMO      128
#define XB_XCNT(j)  (256  + 64 * (j))
#define XB_XSUB(j)  (1280 + 64 * (j))
#define XB_XGEN(j)  (2304 + 64 * (j))
#define XB_TOP      3328
#define XB_TOPGEN   3392
#define XCD_BAR_WORDS 3456
#define XB_SPIN_CAP (1u << 18)


__device__ __forceinline__ unsigned xb_ld(unsigned* p)              { return __hip_atomic_load(p, __ATOMIC_RELAXED, __HIP_MEMORY_SCOPE_AGENT); }
__device__ __forceinline__ unsigned xb_add(unsigned* p, unsigned v) { return __hip_atomic_fetch_add(p, v, __ATOMIC_RELAXED, __HIP_MEMORY_SCOPE_AGENT); }
__device__ __forceinline__ unsigned xb_xcc_id() { return (unsigned)__builtin_amdgcn_s_getreg((3 << 11) | 20) & 0xFu; }
#define XB_SPIN(cond, bar) do { unsigned _sp = 0; while (cond) { __builtin_amdgcn_s_sleep(1); \
    if ((++_sp & 255u) == 0u) { if (xb_ld(&(bar)[XB_TMO])) break; if (_sp > XB_SPIN_CAP) { atomicAdd(&(bar)[XB_TMO], 1u); break; } } } } while (0)

struct XcdBarrier {
    unsigned* bar; unsigned x;
    volatile LAS unsigned* st;
};

__device__ __forceinline__ XcdBarrier xcd_barrier_post(unsigned* bar, volatile LAS unsigned* st) {
    XcdBarrier b; b.bar = bar; b.x = xb_xcc_id(); b.st = st;
    if (threadIdx.x == 0) (void)xb_add(&bar[XB_XCNT(b.x)], 1u);
    return b;
}
__device__ __forceinline__ void xcd_barrier_complete(unsigned* bar, unsigned x, unsigned& nloc, unsigned& nx) {
    const unsigned G = gridDim.x * gridDim.y * gridDim.z;
    unsigned sum, cnt, mine, sp = 0u;
    for (;;) {
        sum = 0u; cnt = 0u; mine = 0u;
#pragma unroll
        for (unsigned j = 0; j < 16; ++j) { const unsigned c = xb_ld(&bar[XB_XCNT(j)]); sum += c; cnt += (c > 0u) ? 1u : 0u; mine = (j == x) ? c : mine; }
        if (sum == G) break;
        __builtin_amdgcn_s_sleep(1);
        if ((++sp & 255u) == 0u) { if (xb_ld(&bar[XB_TMO])) break; if (sp > XB_SPIN_CAP) { atomicAdd(&bar[XB_TMO], 1u); break; } }
    }
    nloc = mine > 0u ? mine : 1u; nx = cnt > 0u ? cnt : 1u;
}

__device__ __forceinline__ void xcd_barrier(const XcdBarrier& b) {
    asm volatile("s_waitcnt vmcnt(0)" ::: "memory");
    __syncthreads();
    if (threadIdx.x == 0) {
        unsigned* bar = b.bar;
        __builtin_amdgcn_s_waitcnt(0);
        unsigned nloc = b.st[0], nx = b.st[1];
        if (nloc == 0u) { xcd_barrier_complete(bar, b.x, nloc, nx); b.st[0] = nloc; b.st[1] = nx; }
        const unsigned old = xb_add(&bar[XB_XSUB(b.x)], 1u);
        const unsigned gen = old / nloc;
        if (old + 1u == (gen + 1u) * nloc) {
            __builtin_amdgcn_fence(__ATOMIC_RELEASE, "agent");
            asm volatile("s_waitcnt vmcnt(0)" ::: "memory");
            const unsigned og = xb_add(&bar[XB_TOP], 1u);
            const unsigned tg = og / nx;
            if (og + 1u == (tg + 1u) * nx) xb_add(&bar[XB_TOPGEN], 1u);
            else XB_SPIN(xb_ld(&bar[XB_TOPGEN]) == tg, bar);
            __builtin_amdgcn_fence(__ATOMIC_ACQUIRE, "agent");
            xb_add(&bar[XB_XGEN(b.x)], 1u);
            asm volatile("s_waitcnt vmcnt(0)" ::: "memory");
        } else {
            XB_SPIN(xb_ld(&bar[XB_XGEN(b.x)]) == gen, bar);
            __builtin_amdgcn_fence(__ATOMIC_ACQUIRE, "agent");
            asm volatile("s_waitcnt vmcnt(0)" ::: "memory");
        }
    }
    __syncthreads();
}


__global__ void __launch_bounds__(512) hybrid_fwd(Params P) {
    cg::grid_group grid = cg::this_grid();
    extern __shared__ __attribute__((aligned(16))) unsigned char smem[];
    LAS unsigned char* lds = (LAS unsigned char*)smem;
    const int bid = blockIdx.x, G = gridDim.x;
    const float* x = P.in[0]; const float* p = P.in[1]; const float* pre_g = P.in[2]; const float* w_in_e = P.in[3];
    const float* q_g = P.in[4]; const float* k_g = P.in[5]; const float* gn_g = P.in[6]; const float* w_out_e = P.in[7];
    const float* w_in_o = P.in[8]; const float* conv_w = P.in[9]; const float* w_out_o = P.in[10]; const float* ple_g = P.in[11];
    const float* w_gate = P.in[12]; const float* w_pp = P.in[13];
    float* out = P.out;

    volatile LAS unsigned* xb_st = (volatile LAS unsigned*)(lds + 139264);
    if (threadIdx.x == 0) { xb_st[0] = 0u; xb_st[1] = 0u; }
    __syncthreads();
    unsigned* xb_words = (unsigned*)(P.ws + WS_BAR);
    XcdBarrier xb; xb.bar = xb_words; xb.x = 0u; xb.st = xb_st;
    for (int step = 0; step < P.nsched; ++step) {
        if (step == 0 && bid == 0) for (int i = threadIdx.x; i < XCD_BAR_WORDS; i += 512) xb_words[i] = 0u;
        const int ph = (int)((P.sched >> (4 * step)) & 15ull);
        int tid = threadIdx.x; asm volatile("" : "+v"(tid));
        const int wid = __builtin_amdgcn_readfirstlane(tid >> 6), lane = tid & 63;
        const size_t gtid = (size_t)bid * 512 + tid, gthreads = (size_t)G * 512;
        __attribute__((address_space(1))) unsigned char* wsg = (__attribute__((address_space(1))) unsigned char*)P.ws; asm volatile("" : "+s"(wsg));
        unsigned char* ws = (unsigned char*)wsg;
        u16* WT_IN = (u16*)(ws + WS_WT_IN); u16* WT_O0 = (u16*)(ws + WS_WT_O0); u16* WT_O1 = (u16*)(ws + WS_WT_O1);
        u16* WT_G0 = (u16*)(ws + WS_WT_G0); u16* WT_G1 = (u16*)(ws + WS_WT_G1); u16* WT_P0 = (u16*)(ws + WS_WT_P0); u16* WT_P1 = (u16*)(ws + WS_WT_P1);
        u16* PROJ = (u16*)(ws + WS_PROJ); u16* XA = (u16*)(ws + WS_XA); u16* XB = (u16*)(ws + WS_XB); u16* PBF = (u16*)(ws + WS_PBF);
        float* RS = (float*)(ws + WS_RS); float* LSE = (float*)(ws + WS_LSE); float* KSS = (float*)(ws + WS_KSS);
        u16* OG = (u16*)out;
        float* ST = (float*)XA;
        u16* RT = XB;
        if (EN_P0 && ph == 0) {
            {
                auto dec = [=](int r) -> TJob { return TJob{w_in_e, WT_IN, pre_g, 2048, NE, r, 2}; };
                transpose_run(dec, 32 * 112, (LAS float*)lds, bid, G, tid);
            }
            for (int row = bid * 8 + wid; row < MROWS; row += G * 8) { const float* xr = x + (size_t)row * DM; u16* orow = XA + (size_t)row * DM; float ss = 0.f;
#pragma unroll
                for (int j = 0; j < 8; ++j) { const int col = 4 * lane + 256 * j; const f32x4 v = __builtin_nontemporal_load((const f32x4*)(xr + col));
                    ss += (v[0] * v[0] + v[1] * v[1]) + (v[2] * v[2] + v[3] * v[3]);
                    u32x2 w; w.x = cvt_pk_bf16(v[0], v[1]); w.y = cvt_pk_bf16(v[2], v[3]); *(u32x2*)(orow + col) = w; }
#pragma unroll
                for (int o = 1; o < 64; o <<= 1) ss += __shfl_xor(ss, o);
                if (lane == 0) RS[row] = ss; }
            for (size_t i = gtid; i < (size_t)3 * MROWS; i += gthreads) RS[MROWS + i] = 0.f;
            for (size_t i = gtid; i < (size_t)8 * MROWS; i += gthreads) KSS[i] = 0.f;
        }
        if (EN_P2 && ph == 2) {
            u32x4 kw0[4], vw0[4], kw1[4], vw1[4], qw[4]; float ks0, ks1;
            for (int it = bid; it < 512; it += G) ret_contrib_item(lds, PROJ, ST, it, tid, wid, lane);
            float qgv[4][8];
#pragma unroll
            for (int ks = 0; ks < 4; ++ks)
#pragma unroll
                for (int j = 0; j < 8; ++j) qgv[ks][j] = q_g[32 * ks + 8 * (lane >> 4) + j] * k_g[32 * ks + 8 * (lane >> 4) + j];
            { const ARun R0 = attn_run(bid < 1024 ? bid : 1023);
              attn_load_half(PROJ, KSS, R0, 0, tid, kw0, vw0, ks0); attn_load_half(PROJ, KSS, R0, 1, tid, kw1, vw1, ks1); attn_load_q(PROJ, R0, 0, wid, lane, qw); }
            for (int rho = bid; rho < 1024; rho += G) { const ARun R = attn_run(rho); const ARun Rnext = attn_run(rho + G < 1024 ? rho + G : rho);
                for (int i = 0; i < R.len; ++i) { const bool last = (i + 1 == R.len);
                    attn_item(lds, PROJ, OG, LSE, KSS, qgv, R, i, last ? Rnext : R, last ? 0 : i + 1, last, kw0, vw0, ks0, kw1, vw1, ks1, qw, tid, wid, lane); } }
        }
        if (EN_P3 && ph == 3) {
            for (size_t i = gtid; i < (size_t)16 * 8192; i += gthreads) { const int bh = (int)(i >> 13), e4 = (int)(i & 8191); const float gc = __expf(ret_log_g(bh & 3) * 128.0f);
                const float* sp = ST + (size_t)bh * 32 * 32768 + (size_t)e4 * 4; u16* rp = RT + (size_t)bh * 32 * 32768 + (size_t)e4 * 4;
                f32x4 R = {0.f, 0.f, 0.f, 0.f};
                for (int n0 = 0; n0 < 32; n0 += 8) { f32x4 sv[8];
#pragma unroll
                    for (int q = 0; q < 8; ++q) sv[q] = __builtin_nontemporal_load((const f32x4*)(sp + (size_t)(n0 + q) * 32768));
#pragma unroll
                    for (int q = 0; q < 8; ++q) { u32x2 w; w.x = cvt_pk_bf16(R[0], R[1]); w.y = cvt_pk_bf16(R[2], R[3]); *(u32x2*)(rp + (size_t)(n0 + q) * 32768) = w; R = R * gc + sv[q]; } } }
        }
        if (EN_P4 && ph == 4) {
            auto merge_patterns = [&]() {
                __syncthreads();
                {
                    constexpr int I_IN1 = 32 * 32, I_SQ = 32 * 8, I_P = 4 * 8;
                    constexpr int NIT = I_IN1 + 4 * I_SQ + 2 * I_P;
                    auto dec = [=](int r) -> TJob {
                        if (r < I_IN1) return TJob{w_in_o, WT_IN, pre_g + 2048, 2048, NO, r, 1}; r -= I_IN1;
                        if (r < I_SQ) return TJob{w_out_e, WT_O0, nullptr, 2048, 2048, r, 2}; r -= I_SQ;
                        if (r < I_SQ) return TJob{w_out_o, WT_O1, nullptr, 2048, 2048, r, 2}; r -= I_SQ;
                        if (r < I_SQ) return TJob{w_gate, WT_G0, ple_g, 2048, 2048, r, 2}; r -= I_SQ;
                        if (r < I_SQ) return TJob{w_gate + (size_t)2048 * 2048, WT_G1, ple_g + 2048, 2048, 2048, r, 2}; r -= I_SQ;
                        if (r < I_P) return TJob{w_pp, WT_P0, nullptr, 256, 2048, r, 2}; r -= I_P;
                        return TJob{w_pp + (size_t)256 * 2048, WT_P1, nullptr, 256, 2048, r, 2}; };
                    transpose_run_big(dec, NIT, (LAS float*)lds, bid, G, tid);
                }
            for (size_t i0 = gtid; i0 < (size_t)2 * MROWS * 256 / 8; i0 += 4 * gthreads) { f32x4 a[4], b2[4];
#pragma unroll
                for (int q = 0; q < 4; ++q) { size_t i = i0 + (size_t)q * gthreads; if (i >= (size_t)2 * MROWS * 256 / 8) i = i0; a[q] = __builtin_nontemporal_load((const f32x4*)(p + i * 8)); b2[q] = __builtin_nontemporal_load((const f32x4*)(p + i * 8 + 4)); }
#pragma unroll
                for (int q = 0; q < 4; ++q) { const size_t i = i0 + (size_t)q * gthreads; if (i < (size_t)2 * MROWS * 256 / 8) {
                    u32x4 w; w.x = cvt_pk_bf16(a[q][0], a[q][1]); w.y = cvt_pk_bf16(a[q][2], a[q][3]); w.z = cvt_pk_bf16(b2[q][0], b2[q][1]); w.w = cvt_pk_bf16(b2[q][2], b2[q][3]); *(u32x4*)(PBF + i * 8) = w; } } }
            for (size_t i0 = gtid; i0 < (size_t)MROWS * 128; i0 += 4 * gthreads) {
                u32x4 w0[4], w1[4], w2[4], wz[4]; float l0[4], l1[4], l2[4];
#pragma unroll
                for (int q = 0; q < 4; ++q) { size_t i = i0 + (size_t)q * gthreads; if (i >= (size_t)MROWS * 128) i = i0; const size_t row = i >> 7; const int c8 = (int)(i & 127), h = c8 >> 4, col = c8 * 8;
                    l0[q] = LSE[row * 8 + h]; l1[q] = LSE[((size_t)MROWS + row) * 8 + h]; l2[q] = LSE[((size_t)2 * MROWS + row) * 8 + h];
                    w0[q] = __builtin_nontemporal_load((const u32x4*)(OG + row * 1024 + col)); w1[q] = __builtin_nontemporal_load((const u32x4*)(OG + ((size_t)MROWS + row) * 1024 + col));
                    w2[q] = __builtin_nontemporal_load((const u32x4*)(OG + ((size_t)2 * MROWS + row) * 1024 + col)); wz[q] = __builtin_nontemporal_load((const u32x4*)(PROJ + row * NE + 6144 + col)); }
#pragma unroll
                for (int q = 0; q < 4; ++q) { const size_t i = i0 + (size_t)q * gthreads; if (i < (size_t)MROWS * 128) { const size_t row = i >> 7; const int col = (int)(i & 127) * 8;
                    const float mm = fmaxf(l0[q], fmaxf(l1[q], l2[q])); float e0 = __expf(l0[q] - mm), e1 = __expf(l1[q] - mm), e2 = __expf(l2[q] - mm); const float inv = __builtin_amdgcn_rcpf(e0 + e1 + e2);
                    e0 *= inv; e1 *= inv; e2 *= inv;
                    float a0[8], a1[8], a2[8], zf[8], r[8];
                    unpack8(w0[q], a0); unpack8(w1[q], a1); unpack8(w2[q], a2); unpack8(wz[q], zf);
#pragma unroll
                    for (int j = 0; j < 8; ++j) r[j] = (e0 * a0[j] + e1 * a1[j] + e2 * a2[j]) * silu_f(zf[j]);
                    *(u32x4*)(XA + row * DM + 1024 + col) = pack8(r); } }
            }
            };
            if (bid & 1) merge_patterns();
            for (int it = bid; it < 512; it += G) ret_out_item(lds, PROJ, RT, gn_g, XA, it, tid, wid, lane);
            if (!(bid & 1)) merge_patterns();
        }
        for (int pass = 0; pass < 2; ++pass) {
        const bool both = (ph == 5 || ph == 9), resid_turn = both && ((pass == 0) == ((bid & 1) == 0));
        if (EN_GR && resid_turn) {
            const bool l1 = (ph == 9);
            if (l1) {
                const float* VS = (const float*)(PROJ + SIDE_OFF); const float* WS = VS + (size_t)256 * 4 * 2048;
                pg8::StaticOrder so0; so0.init(MROWS, DM, G, bid); pg8::Unit uu;
                for (int ui = 0; so0.next(ui, uu); ++ui) {
                    bool seen = false; { pg8::Unit up; for (int uj = 0; uj < ui; ++uj) { so0.next(uj, up); seen = seen || (up.pm == uu.pm); } }
                    if (seen) continue;
                    for (int i = tid; i < 4 * 2 * 512; i += 512) { const int c4 = (i & 511) * 4, fr = (i >> 9) & 1; const size_t b64 = (size_t)uu.pm * 4 + (i >> 10);
                        const bool first = (b64 & 63) == 0;
                        const f32x4 z4 = {0.f, 0.f, 0.f, 0.f};
                        const f32x4 v = *(const f32x4*)(VS + (b64 * 4 + fr) * 2048 + c4), wv = *(const f32x4*)(WS + (b64 * 2 + fr) * 2048 + c4);
                        f32x4 v1, v2;
                        if (fr == 0) { v1 = first ? z4 : *(const f32x4*)(VS + ((b64 - 1) * 4 + 3) * 2048 + c4); v2 = first ? z4 : *(const f32x4*)(VS + ((b64 - 1) * 4 + 2) * 2048 + c4); }
                        else { v1 = *(const f32x4*)(VS + (b64 * 4 + 0) * 2048 + c4); v2 = first ? z4 : *(const f32x4*)(VS + ((b64 - 1) * 4 + 3) * 2048 + c4); }
                        const f32x4 c0 = *(const f32x4*)(conv_w + c4), c1 = *(const f32x4*)(conv_w + 2048 + c4), c2 = *(const f32x4*)(conv_w + 4096 + c4);
                        const f32x4 y = wv * (c2 * v + c1 * v1 + c0 * v2);
                        u32x2 w; w.x = cvt_pk_bf16(y[0], y[1]); w.y = cvt_pk_bf16(y[2], y[3]); *(u32x2*)(XB + (b64 * 64 + fr) * DM + c4) = w; }
                }
                asm volatile("s_waitcnt vmcnt(0)" ::: "memory"); __syncthreads();
            }
            pg8::Gemm g{l1 ? XB : XA, l1 ? WT_O1 : WT_O0, MROWS, DM, 2048, 2048, 2048}; pg8::StaticOrder so; so.init(MROWS, DM, G, bid);
            if (l1) { pg8::EpiResid<false> e{nullptr, XA, XA, RS + 3 * MROWS}; pg8::gemm_phase<pg8::EpiResid<false>, pg8::StaticOrder, false>(lds, g, so, e, nullptr); }
            else { pg8::EpiResid<true> e{x, XA, XB, RS + 1 * MROWS}; pg8::gemm_phase<pg8::EpiResid<true>, pg8::StaticOrder, false>(lds, g, so, e, nullptr); }
        }
        if (EN_GS && ((both && !resid_turn) || (pass == 0 && (ph == 1 || ph == 7)))) {
            pg8::Gemm g; pg8::EpiScaleBf16 e; int N;
            if (ph == 1) { g = pg8::Gemm{XA, WT_IN, MROWS, NE, 2048, 2048, 2048}; e = pg8::EpiScaleBf16{PROJ, NE, RS, nullptr, nullptr, nullptr, KSS}; N = NE; }
            else if (ph == 7) { g = pg8::Gemm{XA, WT_IN, MROWS, NO, 2048, 2048, 2048}; e = pg8::EpiScaleBf16{XB, DM, RS + 2 * MROWS, conv_w, (float*)(PROJ + SIDE_OFF), (float*)(PROJ + SIDE_OFF) + (size_t)256 * 4 * 2048, nullptr}; N = NO; }
            else { const bool l1 = (ph == 9); g = pg8::Gemm{PBF + (l1 ? (size_t)MROWS * 256 : 0), l1 ? WT_P1 : WT_P0, MROWS, DM, 256, 256, 256}; e = pg8::EpiScaleBf16{PROJ, DM, nullptr, nullptr, nullptr, nullptr, nullptr}; N = DM; }
            pg8::StaticOrder so; so.init(MROWS, N, G, bid);
            pg8::gemm_phase<pg8::EpiScaleBf16, pg8::StaticOrder, false>(lds, g, so, e, nullptr);
        }
        }
        if (EN_GG && (ph == 6 || ph == 10)) {
            const bool l1 = (ph == 10);
            pg8::Gemm g{l1 ? XA : XB, l1 ? WT_G1 : WT_G0, MROWS, DM, 2048, 2048, 2048}; pg8::StaticOrder so; so.init(MROWS, DM, G, bid);
            pg8::EpiGate e{RS + (l1 ? 3 : 1) * MROWS, PROJ, l1 ? XA : XB, XA, l1 ? out : (float*)nullptr, RS + 2 * MROWS};
            pg8::gemm_phase<pg8::EpiGate, pg8::StaticOrder, false>(lds, g, so, e, nullptr);
        }
        if (step + 1 < P.nsched) { if (step == 0) { grid.sync(); xb = xcd_barrier_post(xb_words, xb_st); } else xcd_barrier(xb); }
    }
}

extern "C" void kernel_launch(void* const* d_in, const int* in_sizes, int n_in, void* d_out, int out_size, void* d_ws, size_t ws_size, hipStream_t stream) {
    static int grid = 0;
    if (grid == 0) {
        if (n_in != 14 || out_size != MROWS * DM || ws_size < WS_END) { fprintf(stderr, "kernel_launch: unexpected shapes (n_in %d out %d ws %zu need %zu)\n", n_in, out_size, ws_size, (size_t)WS_END); grid = -1; return; }
        int dev = 0, cus = 0, per_cu = 0;
        hipGetDevice(&dev); hipDeviceGetAttribute(&cus, hipDeviceAttributeMultiprocessorCount, dev);
        if (hipFuncSetAttribute((const void*)hybrid_fwd, hipFuncAttributeMaxDynamicSharedMemorySize, LDS_BYTES) != hipSuccess) { fprintf(stderr, "kernel_launch: hipFuncSetAttribute failed\n"); grid = -1; return; }
        if (hipOccupancyMaxActiveBlocksPerMultiprocessor(&per_cu, (const void*)hybrid_fwd, 512, LDS_BYTES) != hipSuccess || per_cu < 1) { fprintf(stderr, "kernel_launch: occupancy query says %d\n", per_cu); (void)hipGetLastError(); per_cu = 1; }
        grid = cus * per_cu;
    }
    if (grid < 0) return;
    Params P{};
    for (int i = 0; i < 14; ++i) P.in[i] = (const float*)d_in[i];
    P.out = (float*)d_out; P.ws = (unsigned char*)d_ws; P.sched = SCHED_BITS; P.nsched = SCHED_N;
    void* args[] = {&P};
    hipError_t e = hipLaunchCooperativeKernel((const void*)hybrid_fwd, dim3(grid), dim3(512), args, LDS_BYTES, stream);
    if (e != hipSuccess) fprintf(stderr, "cooperative launch failed: %s (grid %d)\n", hipGetErrorString(e), grid);
}
```

```cpp
#include <hip/hip_runtime.h>
#include <hip/hip_cooperative_groups.h>
#include <cstdio>
namespace cg = cooperative_groups;
namespace pg8 {
#define PG8_LAS __attribute__((address_space(3)))
typedef unsigned short bf16_t;
typedef short bf16x8 __attribute__((ext_vector_type(8)));
typedef float f32x4 __attribute__((ext_vector_type(4)));
typedef unsigned u32x4 __attribute__((ext_vector_type(4)));
constexpr int BM = 256, BK = 64, HALF = 128, HTB = HALF * BK * 2  , STAGE_BYTES = 8 * HTB, NXCD = 8, WGM = 4;

__host__ __device__ __forceinline__ int lds_byte(int r, int c) { const int st = (r >> 4) * 2 + (c >> 5), rr = r & 15, cc = c & 31, ob = rr * 64 + cc * 2; return st * 1024 + (ob ^ (((ob >> 9) & 1) << 5)); }
__host__ __device__ __forceinline__ void stage_rc(int b, int& R, int& C) { const int st = b / 1024, sb = b % 1024, swz = sb ^ (((sb >> 9) & 1) << 5); R = (st >> 1) * 16 + swz / 64; C = (st & 1) * 32 + (swz % 64) / 2; }
__host__ __device__ __forceinline__ int perm32(int rho) { const int n = rho >> 4, i = rho & 15; return 8 * (i >> 2) + 4 * n + (i & 3); }

struct Unit { int pm, pn; };
struct Gemm { const bf16_t* A; const bf16_t* Bt; int M, N, K, ldA, ldB; };

struct StaticOrder {
    int nM, nN, nwg, G, c;
    __host__ __device__ void init(int M, int N, int G_, int c_) { nM = M / BM; nN = N / BM; nwg = nM * nN; G = G_; c = c_; }
    __host__ __device__ bool next(int i, Unit& u) const {
        const long L = (long)i * G + c; if (L >= nwg) return false;
        int wgid = (int)L; { const int q = nwg / NXCD, r = nwg % NXCD, xcd = wgid % NXCD, off = wgid / NXCD; wgid = (xcd < r ? xcd * (q + 1) : r * (q + 1) + (xcd - r) * q) + off; }
        const int nig = WGM * nN, gid = wgid / nig, fm = gid * WGM, gsz = (nM - fm) < WGM ? (nM - fm) : WGM;
        u.pm = fm + ((wgid % nig) % gsz); u.pn = (wgid % nig) / gsz; return true;
    }
    __device__ __forceinline__ void a_ready(const Unit&) const {}
    __device__ __forceinline__ void done(const Unit&) const {}
};
__device__ __forceinline__ unsigned cvt_pk_bf16(float lo, float hi) { unsigned r; asm volatile("v_cvt_pk_bf16_f32 %0, %1, %2" : "=v"(r) : "v"(lo), "v"(hi)); return r; }
typedef float f32x2 __attribute__((ext_vector_type(2)));
typedef unsigned u32x2 __attribute__((ext_vector_type(2)));
__device__ __forceinline__ float sq4(const f32x4 v) { return (v[0] * v[0] + v[1] * v[1]) + (v[2] * v[2] + v[3] * v[3]); }
template <int CTRL> __device__ __forceinline__ float dpp_ror(float x) { return __int_as_float(__builtin_amdgcn_update_dpp(0, __float_as_int(x), CTRL, 0xf, 0xf, false)); }
struct EpiScaleBf16 {
    static constexpr bool PERM = true, AFTER_DRAIN = false;
    bf16_t* O; int ldc; const float* rs; const float* cw; float* vside; float* wside; float* kss;
    __device__ __forceinline__ void prefetch(const Unit& u, int wr, int fr, float (&rsv)[4]) const {
        const int row0 = u.pm * BM + wr * 64 + fr;
#pragma unroll
        for (int m = 0; m < 4; ++m) rsv[m] = rs ? rs[row0 + m * 16] : 2048.0f;
    }
    __device__ __forceinline__ void operator()(const f32x4 (&acc)[2][2][4][2], const Unit& u, int wr, int wc, int fr, int fq, const float (&rsv)[4]) const {
        if (!cw) {
            const int row0 = u.pm * BM + wr * 64 + fr, col0 = u.pn * BM + wc * 64 + 8 * fq;
            float rs2[4];
#pragma unroll
            for (int m = 0; m < 4; ++m) rs2[m] = rs ? rs[row0 + HALF + m * 16] : 2048.0f;
#pragma unroll
            for (int ai = 0; ai < 2; ++ai)
#pragma unroll
                for (int m = 0; m < 4; ++m) { const int row = row0 + ai * HALF + m * 16;
                    const float sc = rs ? rsqrtf((ai ? rs2[m] : rsv[m]) * (1.0f / 2048.0f) + 1e-6f) : 1.0f;
                    bf16_t* rowp = O + (size_t)row * ldc + col0;
#pragma unroll
                    for (int bj = 0; bj < 2; ++bj) { const f32x4 v0 = acc[ai][bj][m][0] * sc, v1 = acc[ai][bj][m][1] * sc;
                        u32x4 w; w.x = cvt_pk_bf16(v0[0], v0[1]); w.y = cvt_pk_bf16(v0[2], v0[3]); w.z = cvt_pk_bf16(v1[0], v1[1]); w.w = cvt_pk_bf16(v1[2], v1[3]);
                        *(u32x4*)(rowp + bj * 32) = w;
                        if (kss && (u.pn >> 2) == 3) {
                            float ss = sq4(v0) + sq4(v1); ss += __shfl_xor(ss, 16); ss += __shfl_xor(ss, 32);
                            if (fq == 0) atomicAdd(kss + (size_t)row * 8 + 2 * (u.pn - 12) + (wc >> 1), ss); } } }
        } else {
            const int row0 = u.pm * BM + wr * 64 + fr, ch0 = u.pn * 64 + wc * 16 + 4 * fq;
            const f32x4 c0 = *(const f32x4*)(cw + ch0), c1 = *(const f32x4*)(cw + 2048 + ch0), c2 = *(const f32x4*)(cw + 4096 + ch0);
            float rs2[4];
#pragma unroll
            for (int m = 0; m < 4; ++m) rs2[m] = rs[row0 + HALF + m * 16];
#pragma unroll
            for (int ai = 0; ai < 2; ++ai) { f32x4 vprev = {0.f, 0.f, 0.f, 0.f};
                const size_t b64 = (size_t)((u.pm * BM + ai * HALF + wr * 64) >> 6);
#pragma unroll
                for (int m = 0; m < 4; ++m) { const int row = row0 + ai * HALF + m * 16;
                    const float sc = rsqrtf((ai ? rs2[m] : rsv[m]) * (1.0f / 2048.0f) + 1e-6f);
                    const f32x4 Bv = acc[ai][0][m][0] * sc, zv = acc[ai][0][m][1] * sc, Cv = acc[ai][1][m][0] * sc, uv = acc[ai][1][m][1] * sc;
                    const f32x4 v = Cv * uv; f32x4 wv, v1, v2;
#pragma unroll
                    for (int j = 0; j < 4; ++j) { wv[j] = Bv[j] * zv[j] * __builtin_amdgcn_rcpf(1.0f + __expf(-zv[j]));
                        const float a1 = dpp_ror<0x121>(v[j]), p1 = dpp_ror<0x121>(vprev[j]), a2 = dpp_ror<0x122>(v[j]), p2 = dpp_ror<0x122>(vprev[j]);
                        v1[j] = fr >= 1 ? a1 : p1; v2[j] = fr >= 2 ? a2 : p2; }
                    const f32x4 y = wv * (c2 * v + c1 * v1 + c0 * v2);
                    if (m == 0 && fr < 2) { *(f32x4*)(vside + (b64 * 4 + fr) * 2048 + ch0) = v; *(f32x4*)(wside + (b64 * 2 + fr) * 2048 + ch0) = wv; }
                    else { u32x2 w; w.x = cvt_pk_bf16(y[0], y[1]); w.y = cvt_pk_bf16(y[2], y[3]); *(u32x2*)(O + (size_t)row * 2048 + ch0) = w; }
                    if (m == 3 && fr >= 14) *(f32x4*)(vside + (b64 * 4 + 2 + (fr - 14)) * 2048 + ch0) = v;
                    vprev = v; } }
        }
    }
};
__device__ __forceinline__ void unpk8(const u32x4 w, f32x4& lo, f32x4& hi) {
    lo[0] = __uint_as_float(w.x << 16); lo[1] = __uint_as_float(w.x & 0xffff0000u); lo[2] = __uint_as_float(w.y << 16); lo[3] = __uint_as_float(w.y & 0xffff0000u);
    hi[0] = __uint_as_float(w.z << 16); hi[1] = __uint_as_float(w.z & 0xffff0000u); hi[2] = __uint_as_float(w.w << 16); hi[3] = __uint_as_float(w.w & 0xffff0000u); }
__device__ __forceinline__ u32x4 pk8(const f32x4 lo, const f32x4 hi) { u32x4 w; w.x = cvt_pk_bf16(lo[0], lo[1]); w.y = cvt_pk_bf16(lo[2], lo[3]); w.z = cvt_pk_bf16(hi[0], hi[1]); w.w = cvt_pk_bf16(hi[2], hi[3]); return w; }
template <bool F32IN> struct EpiResid {
    static constexpr bool PERM = true, AFTER_DRAIN = false;
    const float* xin32; const bf16_t* xin16; bf16_t* xo; float* rs;
    __device__ __forceinline__ void prefetch(const Unit&, int, int, float (&)[4]) const {}
    typedef f32x4 XBuf[2][2][F32IN ? 2 : 1];
    __device__ __forceinline__ void load2(int c, size_t off0, XBuf& x) const {
#pragma unroll
        for (int g = 0; g < 2; ++g) { const size_t off = off0 + (size_t)((c >> 1) * HALF + (2 * (c & 1) + g) * 16) * 2048;
#pragma unroll
            for (int bj = 0; bj < 2; ++bj) {
                if constexpr (F32IN) { x[g][bj][0] = *(const f32x4*)(xin32 + off + bj * 32); x[g][bj][1] = *(const f32x4*)(xin32 + off + bj * 32 + 4); }
                else x[g][bj][0] = *(const f32x4*)(xin16 + off + bj * 32);     } }
    }
    __device__ __forceinline__ void proc2(const f32x4 (&acc)[2][2][4][2], int c, int row0, size_t off0, int fq, const XBuf& x) const {
        const int ai = c >> 1;
#pragma unroll
        for (int g = 0; g < 2; ++g) { const int m = 2 * (c & 1) + g; const int row = row0 + ai * HALF + m * 16; const size_t off = off0 + (size_t)(ai * HALF + m * 16) * 2048; float s = 0.f;
#pragma unroll
            for (int bj = 0; bj < 2; ++bj) { f32x4 x0, x1;
                if constexpr (F32IN) { x0 = x[g][bj][0]; x1 = x[g][bj][1]; }
                else { const f32x4 r = x[g][bj][0]; u32x4 w; w.x = __float_as_uint(r[0]); w.y = __float_as_uint(r[1]); w.z = __float_as_uint(r[2]); w.w = __float_as_uint(r[3]); unpk8(w, x0, x1); }
                const f32x4 v0 = x0 + acc[ai][bj][m][0], v1 = x1 + acc[ai][bj][m][1];
                s += sq4(v0) + sq4(v1); *(u32x4*)(xo + off + bj * 32) = pk8(v0, v1); }
            s += __shfl_xor(s, 16); s += __shfl_xor(s, 32);
            if (fq == 0) atomicAdd(rs + row, s); }
        asm volatile("" ::: "memory");
    }
    __device__ __forceinline__ void operator()(const f32x4 (&acc)[2][2][4][2], const Unit& u, int wr, int wc, int fr, int fq, const float (&)[4]) const {
        const int row0 = u.pm * BM + wr * 64 + fr, col0 = u.pn * BM + wc * 64 + 8 * fq; const size_t off0 = (size_t)row0 * 2048 + col0;
        XBuf xa, xb;
        load2(0, off0, xa);
        load2(1, off0, xb); proc2(acc, 0, row0, off0, fq, xa);
        load2(2, off0, xa); proc2(acc, 1, row0, off0, fq, xb);
        load2(3, off0, xb); proc2(acc, 2, row0, off0, fq, xa);
        proc2(acc, 3, row0, off0, fq, xb);
    }
};
struct EpiGate {
    static constexpr bool PERM = true, AFTER_DRAIN = false;
    const float* rs_in; const bf16_t* pp; const bf16_t* xin; bf16_t* xo16; float* xo32; float* rs_out;
    __device__ __forceinline__ void prefetch(const Unit& u, int wr, int fr, float (&rsv)[4]) const {
        const int row0 = u.pm * BM + wr * 64 + fr;
#pragma unroll
        for (int m = 0; m < 4; ++m) rsv[m] = rs_in[row0 + m * 16];
    }
    __device__ __forceinline__ void load2(int c, size_t off0, u32x4 (&xw)[2][2], u32x4 (&pw)[2][2]) const {
#pragma unroll
        for (int g = 0; g < 2; ++g) { const size_t off = off0 + (size_t)((c >> 1) * HALF + (2 * (c & 1) + g) * 16) * 2048;
#pragma unroll
            for (int bj = 0; bj < 2; ++bj) { xw[g][bj] = *(const u32x4*)(xin + off + bj * 32); pw[g][bj] = *(const u32x4*)(pp + off + bj * 32); } }
    }
    __device__ __forceinline__ void proc2(const f32x4 (&acc)[2][2][4][2], int c, int row0, size_t off0, int fq, const float (&rsx)[4], const u32x4 (&xw)[2][2], const u32x4 (&pw)[2][2]) const {
        const int ai = c >> 1;
#pragma unroll
        for (int g = 0; g < 2; ++g) { const int m = 2 * (c & 1) + g; const int row = row0 + ai * HALF + m * 16; const size_t off = off0 + (size_t)(ai * HALF + m * 16) * 2048; float s = 0.f;
            const float sc = rsqrtf(rsx[m] * (1.0f / 2048.0f) + 1e-6f);
#pragma unroll
            for (int bj = 0; bj < 2; ++bj) { f32x4 x0, x1, p0, p1; unpk8(xw[g][bj], x0, x1); unpk8(pw[g][bj], p0, p1);
                const f32x4 a0 = acc[ai][bj][m][0] * sc, a1 = acc[ai][bj][m][1] * sc; f32x4 v0, v1;
#pragma unroll
                for (int j = 0; j < 4; ++j) { v0[j] = x0[j] + p0[j] * __builtin_amdgcn_rcpf(1.0f + __expf(-a0[j])); v1[j] = x1[j] + p1[j] * __builtin_amdgcn_rcpf(1.0f + __expf(-a1[j])); }
                if (xo32) { *(f32x4*)(xo32 + off + bj * 32) = v0; *(f32x4*)(xo32 + off + bj * 32 + 4) = v1; }
                else { s += sq4(v0) + sq4(v1); *(u32x4*)(xo16 + off + bj * 32) = pk8(v0, v1); } }
            if (!xo32) { s += __shfl_xor(s, 16); s += __shfl_xor(s, 32); if (fq == 0) atomicAdd(rs_out + row, s); } }
        asm volatile("" ::: "memory");
    }
    __device__ __forceinline__ void operator()(const f32x4 (&acc)[2][2][4][2], const Unit& u, int wr, int wc, int fr, int fq, const float (&rsv)[4]) const {
        const int row0 = u.pm * BM + wr * 64 + fr, col0 = u.pn * BM + wc * 64 + 8 * fq; const size_t off0 = (size_t)row0 * 2048 + col0;
        float rs2[4];
#pragma unroll
        for (int m = 0; m < 4; ++m) rs2[m] = rs_in[row0 + HALF + m * 16];
        u32x4 xa[2][2], pa[2][2], xb[2][2], pb[2][2];
        load2(0, off0, xa, pa);
        load2(1, off0, xb, pb); proc2(acc, 0, row0, off0, fq, rsv, xa, pa);
        load2(2, off0, xa, pa); proc2(acc, 1, row0, off0, fq, rsv, xb, pb);
        load2(3, off0, xb, pb); proc2(acc, 2, row0, off0, fq, rs2, xa, pa);
        proc2(acc, 3, row0, off0, fq, rs2, xb, pb);
    }
};
template <class Epi, class Sched, bool STAMP = false>
__device__ __forceinline__ void gemm_phase(PG8_LAS unsigned char* lds, const Gemm g, const Sched& S, const Epi& E, unsigned long long* stamps) {
    int tid_ = threadIdx.x; asm volatile("" : "+v"(tid_));
    const int tid = tid_, wid = __builtin_amdgcn_readfirstlane(tid >> 6), lane = tid & 63, wr = wid >> 2, wc = wid & 3, fr = lane & 15, fq = lane >> 4;
    const int K = g.K, nt = K / BK;
    int ts_lo = 0, ts_hi = 0, nts = 0; const unsigned long long rt_entry = STAMP ? (unsigned long long)wall_clock64() : 0ull;
#define PG8_STAMP() do { if (STAMP && wid == 0 && nts < 64) { const unsigned long long _c = (unsigned long long)clock64(); \
        ts_lo = (lane == nts) ? (int)(unsigned)_c : ts_lo; ts_hi = (lane == nts) ? (int)(unsigned)(_c >> 32) : ts_hi; ++nts; } } while (0)
    PG8_STAMP();
    unsigned voffA[2], voffB[2];
#pragma unroll
    for (int i = 0; i < 2; ++i) { int R, C; stage_rc(tid * 16 + i * 8192, R, C); const int Rb = Epi::PERM ? ((R & ~31) + perm32(R & 31)) : R;
        voffA[i] = (unsigned)(R * g.ldA + C) * 2u; voffB[i] = (unsigned)(Rb * g.ldB + C) * 2u; }
    const size_t kstep = (size_t)(BK * 2);
    const size_t hstepA = (size_t)HALF * g.ldA * 2, hstepB = (size_t)HALF * g.ldB * 2;
    const size_t tstepA = 2 * hstepA, tstepB = 2 * hstepB;
    const unsigned ldsw = (unsigned)wid * 1024u;
    const int aoff = lds_byte(wr * 64 + fr, fq * 8), boff = lds_byte(wc * 32 + fr, fq * 8);
#define PG8_SA(b, h) (((b) * 2 + (h)) * HTB)
#define PG8_SB(b, h) ((4 + (b) * 2 + (h)) * HTB)
#define PG8_STAGE(bufoff, gbase, voff) do { _Pragma("unroll") for (int _i = 0; _i < 2; ++_i) \
        __builtin_amdgcn_global_load_lds((const unsigned*)((const char*)(gbase) + (voff)[_i]), (PG8_LAS unsigned*)(lds + (bufoff) + ldsw + _i * 8192), 16, 0, 0); } while (0)
#define PG8_LDA(dst, b, h) do { _Pragma("unroll") for (int m = 0; m < 4; ++m) _Pragma("unroll") for (int k = 0; k < 2; ++k) dst[m][k] = *(const PG8_LAS bf16x8*)(lds + PG8_SA(b, h) + aoff + m * 2048 + k * 1024); } while (0)
#define PG8_LDB(dst, b, h) do { _Pragma("unroll") for (int n = 0; n < 2; ++n) _Pragma("unroll") for (int k = 0; k < 2; ++k) dst[n][k] = *(const PG8_LAS bf16x8*)(lds + PG8_SB(b, h) + boff + n * 2048 + k * 1024); } while (0)
#define PG8_MMA(ai, bj, At, Bt) do { __builtin_amdgcn_s_setprio(1); _Pragma("unroll") for (int m = 0; m < 4; ++m) _Pragma("unroll") for (int n = 0; n < 2; ++n) _Pragma("unroll") for (int k = 0; k < 2; ++k) \
        acc[ai][bj][m][n] = __builtin_amdgcn_mfma_f32_16x16x32_bf16(Bt[n][k], At[m][k], acc[ai][bj][m][n], 0, 0, 0); __builtin_amdgcn_s_setprio(0); } while (0)
#define PG8_WAIT_V(n) asm volatile("s_waitcnt vmcnt(" #n ")" ::: "memory")
#define PG8_WAIT_L(n) asm volatile("s_waitcnt lgkmcnt(" #n ")" ::: "memory")
#define PG8_BAR __builtin_amdgcn_s_barrier()
#define PG8_SCHED __builtin_amdgcn_sched_barrier(0)
    Unit cur, nxt; int ui = 0;
    if (!S.next(0, cur)) return;
    f32x4 acc[2][2][4][2];
    float rsv[4];
#pragma unroll
    for (int a = 0; a < 2; ++a)
#pragma unroll
        for (int b = 0; b < 2; ++b)
#pragma unroll
            for (int m = 0; m < 4; ++m)
#pragma unroll
                for (int n = 0; n < 2; ++n) acc[a][b][m][n] = (f32x4){0.f, 0.f, 0.f, 0.f};
    bf16x8 At[4][2], B0[2][2], B1[2][2];
    const char* cA = (const char*)g.A + (size_t)cur.pm * tstepA; const char* cB = (const char*)g.Bt + (size_t)cur.pn * tstepB;
    S.a_ready(cur);
    PG8_STAGE(PG8_SB(0, 0), cB, voffB); PG8_STAGE(PG8_SA(0, 0), cA, voffA); PG8_STAGE(PG8_SB(0, 1), cB + hstepB, voffB); PG8_STAGE(PG8_SA(0, 1), cA + hstepA, voffA);
    if (wr == 1) PG8_BAR;
    PG8_WAIT_V(4); PG8_BAR;
    PG8_STAGE(PG8_SB(1, 0), cB + kstep, voffB); PG8_STAGE(PG8_SA(1, 0), cA + kstep, voffA); PG8_STAGE(PG8_SB(1, 1), cB + hstepB + kstep, voffB);
    PG8_WAIT_V(6); PG8_BAR;
    PG8_STAMP();
    for (;;) {
        const bool has_next = S.next(ui + 1, nxt);
        const char* nA = has_next ? (const char*)g.A + (size_t)nxt.pm * tstepA : cA; const char* nB = has_next ? (const char*)g.Bt + (size_t)nxt.pn * tstepB : cB;
        for (int t = 0; t < nt; t += 2) {
            const bool last = (t == nt - 2);
            const char* a1 = cA + (size_t)(t + 1) * kstep;
            const char* a2 = last ? nA : cA + (size_t)(t + 2) * kstep; const char* b2 = last ? nB : cB + (size_t)(t + 2) * kstep;
            const char* a3 = a2 + kstep; const char* b3 = b2 + kstep;
            if (last && has_next) S.a_ready(nxt);
            if (last) E.prefetch(cur, wr, fr, rsv);
            PG8_LDB(B0, 0, 0); PG8_SCHED; PG8_LDA(At, 0, 0); PG8_STAGE(PG8_SA(1, 1), a1 + hstepA, voffA);
            PG8_WAIT_L(8); PG8_BAR; PG8_WAIT_L(0); PG8_MMA(0, 0, At, B0); PG8_BAR; PG8_SCHED;
            PG8_LDB(B1, 0, 1); PG8_STAGE(PG8_SB(0, 0), b2, voffB);
            PG8_BAR; PG8_WAIT_L(0); PG8_MMA(0, 1, At, B1); PG8_BAR;
            PG8_LDA(At, 0, 1); PG8_STAGE(PG8_SA(0, 0), a2, voffA);
            PG8_BAR; PG8_WAIT_L(0); PG8_MMA(1, 0, At, B0); PG8_BAR; PG8_SCHED;
            PG8_STAGE(PG8_SB(0, 1), b2 + hstepB, voffB);
            PG8_WAIT_V(6); PG8_BAR; PG8_MMA(1, 1, At, B1); PG8_BAR;
            PG8_LDB(B0, 1, 0); PG8_SCHED; PG8_LDA(At, 1, 0); PG8_STAGE(PG8_SA(0, 1), a2 + hstepA, voffA);
            PG8_WAIT_L(8); PG8_BAR; PG8_WAIT_L(0); PG8_MMA(0, 0, At, B0); PG8_BAR; PG8_SCHED;
            PG8_LDB(B1, 1, 1); PG8_STAGE(PG8_SB(1, 0), b3, voffB);
            PG8_BAR; PG8_WAIT_L(0); PG8_MMA(0, 1, At, B1); PG8_BAR;
            PG8_LDA(At, 1, 1); PG8_STAGE(PG8_SA(1, 0), a3, voffA);
            PG8_BAR; PG8_WAIT_L(0); PG8_MMA(1, 0, At, B0); PG8_BAR; PG8_SCHED;
            PG8_STAGE(PG8_SB(1, 1), b3 + hstepB, voffB);
            PG8_WAIT_V(6); PG8_BAR; PG8_MMA(1, 1, At, B1); PG8_BAR;
        }
        PG8_STAMP();
        if constexpr (!Epi::AFTER_DRAIN) { E(acc, cur, wr, wc, fr, fq, rsv); S.done(cur); }
        PG8_STAMP();
        if (!has_next) break;
#pragma unroll
        for (int a = 0; a < 2; ++a)
#pragma unroll
            for (int b = 0; b < 2; ++b)
#pragma unroll
                for (int m = 0; m < 4; ++m)
#pragma unroll
                    for (int n = 0; n < 2; ++n) acc[a][b][m][n] = (f32x4){0.f, 0.f, 0.f, 0.f};
        cur = nxt; cA = nA; cB = nB; ++ui;
    }
    PG8_WAIT_V(0);
    if (wr == 0) PG8_BAR;
    PG8_BAR;
    if constexpr (Epi::AFTER_DRAIN) { E.fused(acc, cur, wr, wc, fr, fq, lds, wid, lane); S.done(cur); }
    PG8_STAMP();
    if (STAMP && wid == 0) { stamps[lane] = lane < nts ? (((unsigned long long)(unsigned)ts_hi << 32) | (unsigned)ts_lo) : 0ull;
        if (lane == 62) stamps[62] = rt_entry; if (lane == 63) stamps[63] = (unsigned long long)wall_clock64(); }
#undef PG8_STAMP
#undef PG8_SA
#undef PG8_SB
#undef PG8_STAGE
#undef PG8_LDA
#undef PG8_LDB
#undef PG8_MMA
#undef PG8_WAIT_V
#undef PG8_WAIT_L
#undef PG8_BAR
#undef PG8_SCHED
}
}
#define LAS __attribute__((address_space(3)))
typedef unsigned short u16;
typedef unsigned int u32;
typedef pg8::bf16x8 bf16x8;
typedef pg8::f32x4 f32x4;
typedef pg8::u32x4 u32x4;
typedef pg8::u32x2 u32x2;
using pg8::cvt_pk_bf16;

constexpr int MROWS = 16384, DM = 2048, SEQ = 4096;
constexpr int NE = 7168, NO = 8192;
constexpr float EPSF = 1e-6f;
constexpr size_t SIDE_OFF = (size_t)64 * 1024 * 1024;
constexpr int LDS_BYTES = 139264 + 16;
#ifndef SCHED_BITS
#define SCHED_BITS 0xA976543210ull
#define SCHED_N 10
#endif

constexpr size_t WS_WT_IN  = 0;
constexpr size_t WS_WT_O0  = WS_WT_IN + (size_t)8192 * 2048 * 2;
constexpr size_t WS_WT_O1  = WS_WT_O0 + (size_t)2048 * 2048 * 2;
constexpr size_t WS_WT_G0  = WS_WT_O1 + (size_t)2048 * 2048 * 2;
constexpr size_t WS_WT_G1  = WS_WT_G0 + (size_t)2048 * 2048 * 2;
constexpr size_t WS_WT_P0  = WS_WT_G1 + (size_t)2048 * 2048 * 2;
constexpr size_t WS_WT_P1  = WS_WT_P0 + (size_t)2048 * 256 * 2;
constexpr size_t WS_PROJ   = WS_WT_P1 + (size_t)2048 * 256 * 2;
constexpr size_t WS_XA     = WS_PROJ + (size_t)16384 * 8192 * 2;
constexpr size_t WS_XB     = WS_XA + (size_t)16384 * 2048 * 2;
constexpr size_t WS_PBF    = WS_XB + (size_t)16384 * 2048 * 2;
constexpr size_t WS_RS     = WS_PBF + (size_t)2 * 16384 * 256 * 2;
constexpr size_t WS_LSE    = WS_RS + (size_t)4 * 16384 * 4;
constexpr size_t WS_BAR    = WS_LSE + (size_t)3 * 16384 * 8 * 4;
constexpr size_t WS_KSS    = WS_BAR + 16384;
constexpr size_t WS_END    = WS_KSS + (size_t)16384 * 8 * 4;

#ifndef EN_P0
#define EN_P0 1
#endif
#ifndef EN_P2
#define EN_P2 1
#endif
#ifndef EN_P3
#define EN_P3 1
#endif
#ifndef EN_P4
#define EN_P4 1
#endif
#ifndef EN_P8
#define EN_P8 1
#endif
#ifndef EN_GR
#define EN_GR 1
#endif
#ifndef EN_GS
#define EN_GS 1
#endif
#ifndef EN_GG
#define EN_GG 1
#endif
struct Params { const float* in[14]; float* out; unsigned char* ws; unsigned long long sched; int nsched, pad_; };

__device__ __forceinline__ float bflo(u32 w) { return __uint_as_float(w << 16); }
__device__ __forceinline__ float bfhi(u32 w) { return __uint_as_float(w & 0xffff0000u); }
__device__ __forceinline__ void unpack8(const u32x4 w, float (&f)[8]) { f[0] = bflo(w.x); f[1] = bfhi(w.x); f[2] = bflo(w.y); f[3] = bfhi(w.y); f[4] = bflo(w.z); f[5] = bfhi(w.z); f[6] = bflo(w.w); f[7] = bfhi(w.w); }
__device__ __forceinline__ u32x4 pack8(const float (&f)[8]) { u32x4 w; w.x = cvt_pk_bf16(f[0], f[1]); w.y = cvt_pk_bf16(f[2], f[3]); w.z = cvt_pk_bf16(f[4], f[5]); w.w = cvt_pk_bf16(f[6], f[7]); return w; }
template <int CTRL> __device__ __forceinline__ float dppf(float x) { return __int_as_float(__builtin_amdgcn_update_dpp(0, __float_as_int(x), CTRL, 0xf, 0xf, true)); }
__device__ __forceinline__ float row16_sum(float s) { s += dppf<0xB1>(s); s += dppf<0x4E>(s); s += dppf<0x124>(s); s += dppf<0x128>(s); return s; }
__device__ __forceinline__ float silu_f(float z) { return z * __builtin_amdgcn_rcpf(1.0f + __expf(-z)); }
__device__ __forceinline__ f32x4 mfma16(bf16x8 a, bf16x8 b, f32x4 c) { return __builtin_amdgcn_mfma_f32_16x16x32_bf16(a, b, c, 0, 0, 0); }

struct TJob { const float* W; u16* WT; const float* gk; int K, N, item, perm; };
__device__ __forceinline__ void t_load(const TJob& j, int tid, f32x4 (&v)[2], float (&gv)[2]) {
    const int nblk = j.N >> 6, kb = j.item / nblk, nb = j.item - kb * nblk, k0 = kb << 6, n0 = nb << 6, ty = tid >> 4, tx = tid & 15;
#pragma unroll
    for (int i = 0; i < 2; ++i) { const int kk = ty + 32 * i; v[i] = __builtin_nontemporal_load((const f32x4*)(j.W + (size_t)(k0 + kk) * j.N + n0 + 4 * tx)); gv[i] = j.gk ? j.gk[k0 + kk] : 1.0f; }
}
template <class Dec>
__device__ __forceinline__ void transpose_run(const Dec& dec, int nitems, LAS float* scr, int bid, int G, int tid) {
    asm volatile("" : "+v"(tid));
    if (bid >= nitems) return;
    f32x4 v[2]; float gv[2];
    { const TJob j0 = dec(bid); t_load(j0, tid, v, gv); }
    const int ty = tid >> 4, tx = tid & 15, n = tid >> 3, c = tid & 7;
    for (int it = bid; it < nitems; it += G) {
        const TJob j = dec(it);
#pragma unroll
        for (int i = 0; i < 2; ++i) { const int kk = ty + 32 * i; const f32x4 t = v[i] * gv[i];
            scr[kk * 65 + 4 * tx + 0] = t[0]; scr[kk * 65 + 4 * tx + 1] = t[1]; scr[kk * 65 + 4 * tx + 2] = t[2]; scr[kk * 65 + 4 * tx + 3] = t[3]; }
        __syncthreads();
        { const int nx = (it + G < nitems) ? it + G : it; const TJob jn = dec(nx); t_load(jn, tid, v, gv); }
        const int nblk = j.N >> 6, kb = j.item / nblk, nb = j.item - kb * nblk, k0 = kb << 6, n0 = nb << 6;
        const LAS float* s = scr + (8 * c) * 65 + n;
        u32x4 o; o.x = cvt_pk_bf16(s[0], s[65]); o.y = cvt_pk_bf16(s[2 * 65], s[3 * 65]); o.z = cvt_pk_bf16(s[4 * 65], s[5 * 65]); o.w = cvt_pk_bf16(s[6 * 65], s[7 * 65]);
        int orow = n0 + n;
        if (j.perm == 1) { const int part = orow >> 11, ch = orow & 2047; orow = 256 * (ch >> 6) + 128 * ((part == 1 || part == 2) ? 1 : 0) + 32 * ((ch >> 4) & 3) + 8 * ((ch >> 2) & 3) + (ch & 3) + ((part >= 2) ? 4 : 0); }
        else if (j.perm == 2) { const int c = orow & 255; orow = (orow & ~255) + 128 * ((c >> 5) & 1) + 32 * (c >> 6) + 8 * ((c >> 3) & 3) + (c & 7); }
        *(u32x4*)(j.WT + (size_t)orow * j.K + k0 + 8 * c) = o;
        __syncthreads();
    }
}

typedef unsigned short u16x4 __attribute__((ext_vector_type(4)));
__device__ __forceinline__ unsigned off_b(unsigned row, unsigned ch) { return 256u * row + 16u * (ch ^ (((row & 3u) << 2) | ((row >> 2) & 3u))); }
__device__ __forceinline__ u16x4 tr_issue(unsigned addr) { u16x4 r; asm volatile("ds_read_b64_tr_b16 %0, %1" : "=&v"(r) : "v"(addr) : "memory"); return r; }
__device__ __forceinline__ bf16x8 tr_join(const u16x4 a, const u16x4 b) { bf16x8 v; v[0] = (short)a[0]; v[1] = (short)a[1]; v[2] = (short)a[2]; v[3] = (short)a[3]; v[4] = (short)b[0]; v[5] = (short)b[1]; v[6] = (short)b[2]; v[7] = (short)b[3]; return v; }
__device__ __forceinline__ unsigned tr_addr(unsigned base, int lane, int ks, int c, int t) {
    const unsigned g = (unsigned)lane >> 4, q4 = ((unsigned)lane & 15u) >> 2, p4 = (unsigned)lane & 3u;
    return base + off_b(32u * ks + 8u * g + 4u * t + q4, 2u * c + (p4 >> 1)) + 8u * (p4 & 1u);
}

struct ARun { int g, b, h, dil, r, n0, len; };
__device__ __forceinline__ ARun attn_run(int rho) {
    ARun R; int bh;
    if (rho < 256) { R.g = 0; R.dil = 1; bh = rho >> 3; R.r = 0; R.n0 = (rho & 7) * 4; R.len = 4; }
    else if (rho < 512) { const int q = rho - 256, tri = q >> 1; R.g = 1; R.dil = 4; bh = tri >> 2; R.r = tri & 3; R.n0 = (q & 1) * 4; R.len = 4; }
    else { const int q = rho - 512; R.g = 2; R.dil = 16; bh = q >> 4; R.r = q & 15; R.n0 = 0; R.len = 2; }
    R.b = bh >> 3; R.h = bh & 7; return R;
}
__device__ __forceinline__ void attn_load_half(const u16* __restrict__ proj, const float* __restrict__ kss, const ARun& R, int k, int tid, u32x4 (&kw)[4], u32x4 (&vw)[4], float& ksr) {
    const int sb = (R.n0 + k - 1) * 128;
    const u16* kbase = proj + (size_t)R.b * SEQ * NE + 3072 + R.h * 128 + (tid & 15) * 8;
#pragma unroll
    for (int i = 0; i < 4; ++i) { int sidx = sb + (tid >> 4) + 32 * i; if (sidx < 0) sidx = 0;
        const size_t t = (size_t)R.r + (size_t)sidx * R.dil;
        kw[i] = *(const u32x4*)(kbase + t * NE); vw[i] = *(const u32x4*)(kbase + t * NE + 1024); }
    { int sidx = sb + (tid & 127); if (sidx < 0) sidx = 0; ksr = kss[((size_t)R.b * SEQ + (size_t)R.r + (size_t)sidx * R.dil) * 8 + R.h]; }
}
__device__ __forceinline__ void attn_load_q(const u16* __restrict__ proj, const ARun& R, int i, int wid, int lane, u32x4 (&qw)[4]) {
    const size_t tq = (size_t)R.r + (size_t)((R.n0 + i) * 128 + 16 * wid + (lane & 15)) * R.dil; const u16* qp = proj + ((size_t)R.b * SEQ + tq) * NE + 2048 + R.h * 128 + 8 * (lane >> 4);
#pragma unroll
    for (int ks = 0; ks < 4; ++ks) qw[ks] = *(const u32x4*)(qp + 32 * ks);
}
__device__ __forceinline__ void attn_item(LAS unsigned char* lds, const u16* __restrict__ proj, u16* __restrict__ og, float* __restrict__ lse, const float* __restrict__ kss,
                                          const float (&qgv)[4][8], const ARun& R, int i, const ARun& Rn, int in, bool nfirst,
                                          u32x4 (&kw0)[4], u32x4 (&vw0)[4], float& ks0, u32x4 (&kw1)[4], u32x4 (&vw1)[4], float& ks1, u32x4 (&qw)[4], int tid, int wid, int lane) {
    asm volatile("" : "+v"(lane), "+v"(tid));
    const int fr = lane & 15, fq = lane >> 4;
    const int g = R.g, h = R.h, dil = R.dil, r = R.r, n = R.n0 + i, par = i & 1;
    const bool first = (i == 0);
    const float slope = exp2f(-(float)(h + 1));
    const size_t rowbase = (size_t)R.b * SEQ;
    LAS unsigned char* Ks = lds;
    LAS unsigned char* Vs = lds + 69632;
    LAS float* rkL = (LAS float*)(lds + 135168);
    __syncthreads();
    {
        const int pc = tid & 15;
        const int slot0 = first ? 0 : ((i + 1) & 1);
#pragma unroll
        for (int q = 0; q < 4; ++q) { const int row = 128 * slot0 + (tid >> 4) + 32 * q;
            *(LAS u32x4*)(Ks + row * 272 + pc * 16) = kw0[q]; *(LAS u32x4*)(Vs + off_b((unsigned)row, (unsigned)pc)) = vw0[q]; }
        if (tid < 128) rkL[128 * slot0 + tid] = rsqrtf(ks0 * (1.0f / 128.0f) + EPSF);
        if (first) {
#pragma unroll
            for (int q = 0; q < 4; ++q) { const int row = 128 + (tid >> 4) + 32 * q;
                *(LAS u32x4*)(Ks + row * 272 + pc * 16) = kw1[q]; *(LAS u32x4*)(Vs + off_b((unsigned)row, (unsigned)pc)) = vw1[q]; }
            if (tid < 128) rkL[128 + tid] = rsqrtf(ks1 * (1.0f / 128.0f) + EPSF);
        }
    }
    const int qi = 16 * wid + fr;
    const size_t tq = (size_t)r + (size_t)(n * 128 + qi) * dil;
    bf16x8 qf[4];
    {
        float qv[4][8]; float ss = 0.f;
#pragma unroll
        for (int ks = 0; ks < 4; ++ks) { unpack8(qw[ks], qv[ks]);
#pragma unroll
            for (int j = 0; j < 8; ++j) ss += qv[ks][j] * qv[ks][j]; }
        ss += __shfl_xor(ss, 16); ss += __shfl_xor(ss, 32);
        const float qs = rsqrtf(ss * (1.0f / 128.0f) + EPSF) * (0.08838834764831845f * 1.4426950408889634f);
#pragma unroll
        for (int ks = 0; ks < 4; ++ks) { float t[8];
#pragma unroll
            for (int j = 0; j < 8; ++j) t[j] = qv[ks][j] * qs * qgv[ks][j];
            qf[ks] = __builtin_bit_cast(bf16x8, pack8(t)); }
    }
    __syncthreads();
    const int kt0 = 2 * (wid >> 1);
    const int px = par << 7;
    f32x4 s[10];
#pragma unroll
    for (int j = 0; j < 10; ++j) { f32x4 acc = {0.f, 0.f, 0.f, 0.f};
#pragma unroll
        for (int ks = 0; ks < 4; ++ks) { const bf16x8 kf = *(const LAS bf16x8*)(Ks + ((16 * (kt0 + j) + fr) ^ px) * 272 + (32 * ks + 8 * fq) * 2); acc = mfma16(kf, qf[ks], acc); }
        s[j] = acc; __builtin_amdgcn_sched_barrier(0); }
    const float sl2 = slope * (float)dil * 1.4426950408889634f;
    const int C0 = qi - 16 * kt0 - 4 * fq + 128;
    int LO = C0 - 128; if (n == 0) LO = max(LO, 128 - 16 * kt0 - 4 * fq);
    const unsigned range = (unsigned)(C0 - LO);
    const float b0 = -sl2 * (float)C0;
    f32x4 rk[10];
#pragma unroll
    for (int j = 0; j < 10; ++j) rk[j] = *(const LAS f32x4*)(rkL + ((16 * (kt0 + j) + 4 * fq) ^ px));
    float mx = -3.0e38f;
#pragma unroll
    for (int j = 0; j < 10; ++j)
#pragma unroll
        for (int ii = 0; ii < 4; ++ii) { const int cji = 16 * j + ii;
            const float v0 = fmaf(sl2, (float)cji, fmaf(s[j][ii], rk[j][ii], b0));
            const float v = ((unsigned)(cji - LO) <= range) ? v0 : -1.0e30f; s[j][ii] = v; mx = fmaxf(mx, v); }
    mx = fmaxf(mx, __shfl_xor(mx, 16)); mx = fmaxf(mx, __shfl_xor(mx, 32));
    float l = 0.f;
#pragma unroll
    for (int j = 0; j < 10; ++j)
#pragma unroll
        for (int ii = 0; ii < 4; ++ii) { const float p = __builtin_amdgcn_exp2f(s[j][ii] - mx); s[j][ii] = p; l += p; }
    l += __shfl_xor(l, 16); l += __shfl_xor(l, 32);
    bf16x8 pf[5];
#pragma unroll
    for (int k5 = 0; k5 < 5; ++k5) { u32x4 w; w.x = cvt_pk_bf16(s[2 * k5][0], s[2 * k5][1]); w.y = cvt_pk_bf16(s[2 * k5][2], s[2 * k5][3]);
        w.z = cvt_pk_bf16(s[2 * k5 + 1][0], s[2 * k5 + 1][1]); w.w = cvt_pk_bf16(s[2 * k5 + 1][2], s[2 * k5 + 1][3]); pf[k5] = __builtin_bit_cast(bf16x8, w); }
    attn_load_half(proj, kss, Rn, nfirst ? 0 : in + 1, tid, kw0, vw0, ks0);
    if (nfirst) attn_load_half(proj, kss, Rn, 1, tid, kw1, vw1, ks1);
    attn_load_q(proj, Rn, in, wid, lane, qw);
    f32x4 o[8];
#pragma unroll
    for (int dt = 0; dt < 8; ++dt) o[dt] = (f32x4){0.f, 0.f, 0.f, 0.f};
    {
        unsigned va_addr[8][2];
        { const unsigned q4 = ((unsigned)lane & 15u) >> 2, p4 = (unsigned)lane & 3u;
#pragma unroll
          for (int t = 0; t < 2; ++t)
#pragma unroll
            for (int dt = 0; dt < 8; ++dt) va_addr[dt][t] = (unsigned)(size_t)Vs + off_b(16u * t + 4u * fq + q4, 2u * dt + (p4 >> 1)) + 8u * (p4 & 1u); }
#pragma unroll
        for (int k5 = 0; k5 < 5; ++k5) { const unsigned koff = 8192u * (unsigned)(((wid >> 1) + k5) ^ (par << 2)); u16x4 va[8][2];
#pragma unroll
            for (int t = 0; t < 2; ++t)
#pragma unroll
                for (int dt = 0; dt < 8; ++dt) va[dt][t] = tr_issue(va_addr[dt][t] + koff);
            asm volatile("s_waitcnt lgkmcnt(0)" : "+v"(va[0][0]), "+v"(va[0][1]), "+v"(va[1][0]), "+v"(va[1][1]), "+v"(va[2][0]), "+v"(va[2][1]), "+v"(va[3][0]), "+v"(va[3][1]),
                                                   "+v"(va[4][0]), "+v"(va[4][1]), "+v"(va[5][0]), "+v"(va[5][1]), "+v"(va[6][0]), "+v"(va[6][1]), "+v"(va[7][0]), "+v"(va[7][1]) :: "memory");
#pragma unroll
            for (int dt = 0; dt < 8; ++dt) o[dt] = mfma16(tr_join(va[dt][0], va[dt][1]), pf[k5], o[dt]);
            __builtin_amdgcn_sched_barrier(0); }
    }
    const float inv = __builtin_amdgcn_rcpf(l);
    const size_t orow = (size_t)g * MROWS + rowbase + tq;
    u16* op = og + orow * 1024 + h * 128 + 4 * fq;
#pragma unroll
    for (int dt = 0; dt < 8; ++dt) { u32x2 w; w.x = cvt_pk_bf16(o[dt][0] * inv, o[dt][1] * inv); w.y = cvt_pk_bf16(o[dt][2] * inv, o[dt][3] * inv); *(u32x2*)(op + 16 * dt) = w; }
    if (fq == 0) lse[orow * 8 + h] = (mx + __builtin_amdgcn_logf(l)) * 0.6931471805599453f;
}

__device__ __forceinline__ float ret_log_g(int h) { return __logf(1.0f - exp2f(-5.0f - (float)h)); }

__device__ __forceinline__ void ret_contrib_item(LAS unsigned char* lds, const u16* __restrict__ proj, u16* __restrict__ ST, int item, int tid, int wid, int lane) {
    asm volatile("" : "+v"(lane), "+v"(tid));
    const int fr = lane & 15, fq = lane >> 4;
    const int bh = item >> 5, n = item & 31, b = bh >> 2, h = bh & 3;
    const size_t row0 = (size_t)b * SEQ + (size_t)n * 128;
    const u16* kbase = proj + row0 * NE + 512 + h * 128;
    const u16* vbase = proj + row0 * NE + 1024 + h * 256;
    const float lg = ret_log_g(h);
    LAS unsigned char* Ks = lds;
    LAS unsigned char* Vs = lds + 32768;
    u32x4 kw[4], vw[8];
#pragma unroll
    for (int i = 0; i < 4; ++i) { const int p = tid + 512 * i; kw[i] = *(const u32x4*)(kbase + (size_t)(p >> 4) * NE + (p & 15) * 8); }
#pragma unroll
    for (int i = 0; i < 8; ++i) { const int p = tid + 512 * i; vw[i] = *(const u32x4*)(vbase + (size_t)(p >> 5) * NE + (p & 31) * 8); }
    __syncthreads();
#pragma unroll
    for (int i = 0; i < 4; ++i) { const int p = tid + 512 * i, sI = p >> 4, pc = p & 15;
        const float zs = __expf(lg * (float)(127 - sI)) * 0.08838834764831845f;
        float f[8]; unpack8(kw[i], f);
#pragma unroll
        for (int j = 0; j < 8; ++j) f[j] *= zs;
        *(LAS u32x4*)(Ks + off_b((unsigned)sI, (unsigned)pc)) = pack8(f); }
#pragma unroll
    for (int i = 0; i < 8; ++i) { const int p = tid + 512 * i, sI = p >> 5, pc = p & 31;
        *(LAS u32x4*)(Vs + (pc >> 4) * 32768 + off_b((unsigned)sI, (unsigned)(pc & 15))) = vw[i]; }
    __syncthreads();
    f32x4 acc[2][8];
#pragma unroll
    for (int mt = 0; mt < 2; ++mt)
#pragma unroll
        for (int nt = 0; nt < 8; ++nt) acc[mt][nt] = (f32x4){0.f, 0.f, 0.f, 0.f};
    const unsigned kb = (unsigned)(size_t)Ks, vb = (unsigned)(size_t)Vs + (unsigned)(wid >> 2) * 32768u;
#pragma unroll
    for (int ks = 0; ks < 4; ++ks) {
        u16x4 ka[8][2], va[2][2];
#pragma unroll
        for (int t = 0; t < 2; ++t) {
#pragma unroll
            for (int nt = 0; nt < 8; ++nt) ka[nt][t] = tr_issue(tr_addr(kb, lane, ks, nt, t));
#pragma unroll
            for (int mt = 0; mt < 2; ++mt) va[mt][t] = tr_issue(tr_addr(vb, lane, ks, 2 * (wid & 3) + mt, t)); }
        asm volatile("s_waitcnt lgkmcnt(0)" : "+v"(ka[0][0]), "+v"(ka[0][1]), "+v"(ka[1][0]), "+v"(ka[1][1]), "+v"(ka[2][0]), "+v"(ka[2][1]), "+v"(ka[3][0]), "+v"(ka[3][1]),
                                               "+v"(ka[4][0]), "+v"(ka[4][1]), "+v"(ka[5][0]), "+v"(ka[5][1]), "+v"(ka[6][0]), "+v"(ka[6][1]), "+v"(ka[7][0]), "+v"(ka[7][1]),
                                               "+v"(va[0][0]), "+v"(va[0][1]), "+v"(va[1][0]), "+v"(va[1][1]) :: "memory");
        const bf16x8 vf0 = tr_join(va[0][0], va[0][1]), vf1 = tr_join(va[1][0], va[1][1]);
#pragma unroll
        for (int nt = 0; nt < 8; ++nt) { const bf16x8 kf = tr_join(ka[nt][0], ka[nt][1]); acc[0][nt] = mfma16(kf, vf0, acc[0][nt]); acc[1][nt] = mfma16(kf, vf1, acc[1][nt]); }
        __builtin_amdgcn_sched_barrier(0); }
    u16* out = ST + (size_t)item * 32768;
#pragma unroll
    for (int mt = 0; mt < 2; ++mt)
#pragma unroll
        for (int nt = 0; nt < 8; ++nt) { u32x2 w; w.x = cvt_pk_bf16(acc[mt][nt][0], acc[mt][nt][1]); w.y = cvt_pk_bf16(acc[mt][nt][2], acc[mt][nt][3]); *(u32x2*)(out + (32 * wid + 16 * mt + fr) * 128 + 16 * nt + 4 * fq) = w; }
}

__device__ __forceinline__ void ret_out_item(LAS unsigned char* lds, const u16* __restrict__ proj, const u16* __restrict__ RT, const float* __restrict__ gn, u16* __restrict__ y0,
                                             int item, int tid, int wid, int lane) {
    asm volatile("" : "+v"(lane), "+v"(tid));
    const int fr = lane & 15, fq = lane >> 4;
    const int bh = item >> 5, n = item & 31, b = bh >> 2, h = bh & 3;
    const size_t row0 = (size_t)b * SEQ + (size_t)n * 128;
    const u16* qbase = proj + row0 * NE + h * 128;
    const u16* kbase = proj + row0 * NE + 512 + h * 128;
    const u16* vbase = proj + row0 * NE + 1024 + h * 256;
    const u16* zbase = proj + row0 * NE + 5120 + h * 256;
    const u16* rtb = RT + (size_t)item * 32768;
    const float lg = ret_log_g(h);
    LAS unsigned char* Ks = lds;
    LAS unsigned char* Ps = lds + 34816;
    LAS unsigned char* Vh = lds + 69632;
    LAS unsigned char* Rh = lds + 102400;
    u32x4 kw[4], vw[4], rw[4];
#pragma unroll
    for (int i = 0; i < 4; ++i) { const int p = tid + 512 * i, sI = p >> 4, pc = p & 15;
        kw[i] = *(const u32x4*)(kbase + (size_t)sI * NE + pc * 8); vw[i] = *(const u32x4*)(vbase + (size_t)sI * NE + pc * 8); rw[i] = *(const u32x4*)(rtb + (size_t)sI * 128 + pc * 8); }
    const int c = 16 * wid + fr;
    bf16x8 qf[4], qx[4];
    {
        const u16* qp = qbase + (size_t)c * NE; const float xi = __expf(lg * (float)(c + 1));
#pragma unroll
        for (int ks = 0; ks < 4; ++ks) { const u32x4 w = *(const u32x4*)(qp + 32 * ks + 8 * fq); qf[ks] = __builtin_bit_cast(bf16x8, w);
            float f[8]; unpack8(w, f);
#pragma unroll
            for (int j = 0; j < 8; ++j) f[j] *= xi;
            qx[ks] = __builtin_bit_cast(bf16x8, pack8(f)); }
    }
    __syncthreads();
#pragma unroll
    for (int i = 0; i < 4; ++i) { const int p = tid + 512 * i, sI = p >> 4, pc = p & 15;
        *(LAS u32x4*)(Ks + sI * 272 + pc * 16) = kw[i]; *(LAS u32x4*)(Vh + off_b((unsigned)sI, (unsigned)pc)) = vw[i]; *(LAS u32x4*)(Rh + sI * 272 + pc * 16) = rw[i]; }
#pragma unroll
    for (int i = 0; i < 4; ++i) { const int p = tid + 512 * i, sI = p >> 4, pc = p & 15;
        vw[i] = *(const u32x4*)(vbase + (size_t)sI * NE + 128 + pc * 8); rw[i] = *(const u32x4*)(rtb + (size_t)(128 + sI) * 128 + pc * 8); }
    __syncthreads();
#pragma unroll
    for (int st = 0; st < 8; ++st) {
        u32x2 w; w.x = 0u; w.y = 0u;
        if (st <= wid) { f32x4 acc = {0.f, 0.f, 0.f, 0.f};
#pragma unroll
            for (int ks = 0; ks < 4; ++ks) { const bf16x8 kf = *(const LAS bf16x8*)(Ks + (16 * st + fr) * 272 + (32 * ks + 8 * fq) * 2); acc = mfma16(kf, qf[ks], acc); }
            float pv[4];
#pragma unroll
            for (int i = 0; i < 4; ++i) { const int d = c - (16 * st + 4 * fq + i); pv[i] = (d >= 0) ? acc[i] * 0.08838834764831845f * __expf(lg * (float)d) : 0.f; }
            w.x = cvt_pk_bf16(pv[0], pv[1]); w.y = cvt_pk_bf16(pv[2], pv[3]); }
        *(LAS u32x2*)(Ps + c * 272 + (16 * st + 4 * fq) * 2) = w; __builtin_amdgcn_sched_barrier(0);
    }
    f32x4 y[2][8];
#pragma unroll
    for (int hf = 0; hf < 2; ++hf)
#pragma unroll
        for (int vt = 0; vt < 8; ++vt) y[hf][vt] = (f32x4){0.f, 0.f, 0.f, 0.f};
    const unsigned vhb = (unsigned)(size_t)Vh;
#pragma unroll
    for (int hf = 0; hf < 2; ++hf) {
        if (hf == 1) {
            __syncthreads();
#pragma unroll
            for (int i = 0; i < 4; ++i) { const int p = tid + 512 * i, sI = p >> 4, pc = p & 15;
                *(LAS u32x4*)(Vh + off_b((unsigned)sI, (unsigned)pc)) = vw[i]; *(LAS u32x4*)(Rh + sI * 272 + pc * 16) = rw[i]; }
            __syncthreads();
        }
#pragma unroll
        for (int ks = 0; ks < 4; ++ks) { const bf16x8 pf = *(const LAS bf16x8*)(Ps + c * 272 + (32 * ks + 8 * fq) * 2);
            u16x4 va[8][2];
#pragma unroll
            for (int t = 0; t < 2; ++t)
#pragma unroll
                for (int vt = 0; vt < 8; ++vt) va[vt][t] = tr_issue(tr_addr(vhb, lane, ks, vt, t));
            asm volatile("s_waitcnt lgkmcnt(0)" : "+v"(va[0][0]), "+v"(va[0][1]), "+v"(va[1][0]), "+v"(va[1][1]), "+v"(va[2][0]), "+v"(va[2][1]), "+v"(va[3][0]), "+v"(va[3][1]),
                                                   "+v"(va[4][0]), "+v"(va[4][1]), "+v"(va[5][0]), "+v"(va[5][1]), "+v"(va[6][0]), "+v"(va[6][1]), "+v"(va[7][0]), "+v"(va[7][1]) :: "memory");
#pragma unroll
            for (int vt = 0; vt < 8; ++vt) y[hf][vt] = mfma16(tr_join(va[vt][0], va[vt][1]), pf, y[hf][vt]);
            __builtin_amdgcn_sched_barrier(0); }
#pragma unroll
        for (int ks = 0; ks < 4; ++ks) {
#pragma unroll
            for (int vt = 0; vt < 8; ++vt) { const bf16x8 rf = *(const LAS bf16x8*)(Rh + (16 * vt + fr) * 272 + (32 * ks + 8 * fq) * 2); y[hf][vt] = mfma16(rf, qx[ks], y[hf][vt]); } __builtin_amdgcn_sched_barrier(0); }
#pragma unroll
        for (int vt = 0; vt < 8; ++vt) asm volatile("" : "+v"(y[hf][vt]));
    }
    float sum = 0.f;
#pragma unroll
    for (int hf = 0; hf < 2; ++hf)
#pragma unroll
        for (int vt = 0; vt < 8; ++vt) sum += (y[hf][vt][0] + y[hf][vt][1]) + (y[hf][vt][2] + y[hf][vt][3]);
    sum += __shfl_xor(sum, 16); sum += __shfl_xor(sum, 32);
    const float mu = sum * (1.0f / 256.0f);
    float var = 0.f;
#pragma unroll
    for (int hf = 0; hf < 2; ++hf)
#pragma unroll
        for (int vt = 0; vt < 8; ++vt) { const f32x4 d = y[hf][vt] - mu; var += (d[0] * d[0] + d[1] * d[1]) + (d[2] * d[2] + d[3] * d[3]); }
    var += __shfl_xor(var, 16); var += __shfl_xor(var, 32);
    const float rstd = rsqrtf(var * (1.0f / 256.0f) + EPSF);
    const u16* zp = zbase + (size_t)c * NE;
    u16* yp = y0 + (row0 + c) * DM + h * 256;
#pragma unroll
    for (int hf = 0; hf < 2; ++hf)
#pragma unroll
        for (int vt = 0; vt < 8; ++vt) { const int v = 128 * hf + 16 * vt + 4 * fq;
            const f32x4 gv = *(const f32x4*)(gn + h * 256 + v); const u32x2 zw = *(const u32x2*)(zp + v);
            const float z0 = bflo(zw.x), z1 = bfhi(zw.x), z2 = bflo(zw.y), z3 = bfhi(zw.y);
            const f32x4 t = (y[hf][vt] - mu) * rstd * gv;
            u32x2 w; w.x = cvt_pk_bf16(t[0] * silu_f(z0), t[1] * silu_f(z1)); w.y = cvt_pk_bf16(t[2] * silu_f(z2), t[3] * silu_f(z3));
            *(u32x2*)(yp + v) = w; }
}

#define XB_TMO      128
#define XB_XCNT(j)  (256  + 64 * (j))
#define XB_XSUB(j)  (1280 + 64 * (j))
#define XB_XGEN(j)  (2304 + 64 * (j))
#define XB_TOP      3328
#define XB_TOPGEN   3392
#define XCD_BAR_WORDS 3456
#define XB_SPIN_CAP (1u << 18)


__device__ __forceinline__ unsigned xb_ld(unsigned* p)              { return __hip_atomic_load(p, __ATOMIC_RELAXED, __HIP_MEMORY_SCOPE_AGENT); }
__device__ __forceinline__ unsigned xb_add(unsigned* p, unsigned v) { return __hip_atomic_fetch_add(p, v, __ATOMIC_RELAXED, __HIP_MEMORY_SCOPE_AGENT); }
__device__ __forceinline__ unsigned xb_xcc_id() { return (unsigned)__builtin_amdgcn_s_getreg((3 << 11) | 20) & 0xFu; }
#define XB_SPIN(cond, bar) do { unsigned _sp = 0; while (cond) { __builtin_amdgcn_s_sleep(1); \
    if ((++_sp & 255u) == 0u) { if (xb_ld(&(bar)[XB_TMO])) break; if (_sp > XB_SPIN_CAP) { atomicAdd(&(bar)[XB_TMO], 1u); break; } } } } while (0)

struct XcdBarrier {
    unsigned* bar; unsigned x;
    volatile LAS unsigned* st;
};

__device__ __forceinline__ XcdBarrier xcd_barrier_post(unsigned* bar, volatile LAS unsigned* st) {
    XcdBarrier b; b.bar = bar; b.x = xb_xcc_id(); b.st = st;
    if (threadIdx.x == 0) (void)xb_add(&bar[XB_XCNT(b.x)], 1u);
    return b;
}
__device__ __forceinline__ void xcd_barrier_complete(unsigned* bar, unsigned x, unsigned& nloc, unsigned& nx) {
    const unsigned G = gridDim.x * gridDim.y * gridDim.z;
    unsigned sum, cnt, mine, sp = 0u;
    for (;;) {
        sum = 0u; cnt = 0u; mine = 0u;
#pragma unroll
        for (unsigned j = 0; j < 16; ++j) { const unsigned c = xb_ld(&bar[XB_XCNT(j)]); sum += c; cnt += (c > 0u) ? 1u : 0u; mine = (j == x) ? c : mine; }
        if (sum == G) break;
        __builtin_amdgcn_s_sleep(1);
        if ((++sp & 255u) == 0u) { if (xb_ld(&bar[XB_TMO])) break; if (sp > XB_SPIN_CAP) { atomicAdd(&bar[XB_TMO], 1u); break; } }
    }
    nloc = mine > 0u ? mine : 1u; nx = cnt > 0u ? cnt : 1u;
}

__device__ __forceinline__ void xcd_barrier(const XcdBarrier& b) {
    asm volatile("s_waitcnt vmcnt(0)" ::: "memory");
    __syncthreads();
    if (threadIdx.x == 0) {
        unsigned* bar = b.bar;
        __builtin_amdgcn_s_waitcnt(0);
        unsigned nloc = b.st[0], nx = b.st[1];
        if (nloc == 0u) { xcd_barrier_complete(bar, b.x, nloc, nx); b.st[0] = nloc; b.st[1] = nx; }
        const unsigned old = xb_add(&bar[XB_XSUB(b.x)], 1u);
        const unsigned gen = old / nloc;
        if (old + 1u == (gen + 1u) * nloc) {
            __builtin_amdgcn_fence(__ATOMIC_RELEASE, "agent");
            asm volatile("s_waitcnt vmcnt(0)" ::: "memory");
            const unsigned og = xb_add(&bar[XB_TOP], 1u);
            const unsigned tg = og / nx;
            if (og + 1u == (tg + 1u) * nx) xb_add(&bar[XB_TOPGEN], 1u);
            else XB_SPIN(xb_ld(&bar[XB_TOPGEN]) == tg, bar);
            __builtin_amdgcn_fence(__ATOMIC_ACQUIRE, "agent");
            xb_add(&bar[XB_XGEN(b.x)], 1u);
            asm volatile("s_waitcnt vmcnt(0)" ::: "memory");
        } else {
            XB_SPIN(xb_ld(&bar[XB_XGEN(b.x)]) == gen, bar);
            __builtin_amdgcn_fence(__ATOMIC_ACQUIRE, "agent");
            asm volatile("s_waitcnt vmcnt(0)" ::: "memory");
        }
    }
    __syncthreads();
}


__global__ void __launch_bounds__(512) hybrid_fwd(Params P) {
    cg::grid_group grid = cg::this_grid();
    extern __shared__ __attribute__((aligned(16))) unsigned char smem[];
    LAS unsigned char* lds = (LAS unsigned char*)smem;
    const int bid = blockIdx.x, G = gridDim.x;
    const float* x = P.in[0]; const float* p = P.in[1]; const float* pre_g = P.in[2]; const float* w_in_e = P.in[3];
    const float* q_g = P.in[4]; const float* k_g = P.in[5]; const float* gn_g = P.in[6]; const float* w_out_e = P.in[7];
    const float* w_in_o = P.in[8]; const float* conv_w = P.in[9]; const float* w_out_o = P.in[10]; const float* ple_g = P.in[11];
    const float* w_gate = P.in[12]; const float* w_pp = P.in[13];
    float* out = P.out;

    volatile LAS unsigned* xb_st = (volatile LAS unsigned*)(lds + 139264);
    if (threadIdx.x == 0) { xb_st[0] = 0u; xb_st[1] = 0u; }
    __syncthreads();
    unsigned* xb_words = (unsigned*)(P.ws + WS_BAR);
    XcdBarrier xb; xb.bar = xb_words; xb.x = 0u; xb.st = xb_st;
    for (int step = 0; step < P.nsched; ++step) {
        if (step == 0 && bid == 0) for (int i = threadIdx.x; i < XCD_BAR_WORDS; i += 512) xb_words[i] = 0u;
        const int ph = (int)((P.sched >> (4 * step)) & 15ull);
        int tid = threadIdx.x; asm volatile("" : "+v"(tid));
        const int wid = __builtin_amdgcn_readfirstlane(tid >> 6), lane = tid & 63;
        const size_t gtid = (size_t)bid * 512 + tid, gthreads = (size_t)G * 512;
        __attribute__((address_space(1))) unsigned char* wsg = (__attribute__((address_space(1))) unsigned char*)P.ws; asm volatile("" : "+s"(wsg));
        unsigned char* ws = (unsigned char*)wsg;
        u16* WT_IN = (u16*)(ws + WS_WT_IN); u16* WT_O0 = (u16*)(ws + WS_WT_O0); u16* WT_O1 = (u16*)(ws + WS_WT_O1);
        u16* WT_G0 = (u16*)(ws + WS_WT_G0); u16* WT_G1 = (u16*)(ws + WS_WT_G1); u16* WT_P0 = (u16*)(ws + WS_WT_P0); u16* WT_P1 = (u16*)(ws + WS_WT_P1);
        u16* PROJ = (u16*)(ws + WS_PROJ); u16* XA = (u16*)(ws + WS_XA); u16* XB = (u16*)(ws + WS_XB); u16* PBF = (u16*)(ws + WS_PBF);
        float* RS = (float*)(ws + WS_RS); float* LSE = (float*)(ws + WS_LSE); float* KSS = (float*)(ws + WS_KSS);
        u16* OG = (u16*)out;
        u16* ST = XA;
        u16* RT = XB;
        if (EN_P0 && ph == 0) {
            {
                constexpr int I_IN = 32 * 112, I_SQ = 32 * 32, I_P = 4 * 32;
                constexpr int NIT = I_IN + 4 * I_SQ + 2 * I_P;
                auto dec = [=](int r) -> TJob {
                    if (r < I_IN) return TJob{w_in_e, WT_IN, pre_g, 2048, NE, r, 2}; r -= I_IN;
                    if (r < I_SQ) return TJob{w_out_e, WT_O0, nullptr, 2048, 2048, r, 2}; r -= I_SQ;
                    if (r < I_SQ) return TJob{w_out_o, WT_O1, nullptr, 2048, 2048, r, 2}; r -= I_SQ;
                    if (r < I_SQ) return TJob{w_gate, WT_G0, ple_g, 2048, 2048, r, 2}; r -= I_SQ;
                    if (r < I_SQ) return TJob{w_gate + (size_t)2048 * 2048, WT_G1, ple_g + 2048, 2048, 2048, r, 2}; r -= I_SQ;
                    if (r < I_P) return TJob{w_pp, WT_P0, nullptr, 256, 2048, r, 2}; r -= I_P;
                    return TJob{w_pp + (size_t)256 * 2048, WT_P1, nullptr, 256, 2048, r, 2}; };
                transpose_run(dec, NIT, (LAS float*)lds, bid, G, tid);
            }
            for (int row = bid * 8 + wid; row < MROWS; row += G * 8) { const float* xr = x + (size_t)row * DM; u16* orow = XA + (size_t)row * DM; float ss = 0.f;
#pragma unroll
                for (int j = 0; j < 8; ++j) { const int col = 4 * lane + 256 * j; const f32x4 v = __builtin_nontemporal_load((const f32x4*)(xr + col));
                    ss += (v[0] * v[0] + v[1] * v[1]) + (v[2] * v[2] + v[3] * v[3]);
                    u32x2 w; w.x = cvt_pk_bf16(v[0], v[1]); w.y = cvt_pk_bf16(v[2], v[3]); *(u32x2*)(orow + col) = w; }
#pragma unroll
                for (int o = 1; o < 64; o <<= 1) ss += __shfl_xor(ss, o);
                if (lane == 0) RS[row] = ss; }
            for (size_t i0 = gtid; i0 < (size_t)2 * MROWS * 256 / 8; i0 += 4 * gthreads) { f32x4 a[4], b2[4];
#pragma unroll
                for (int q = 0; q < 4; ++q) { size_t i = i0 + (size_t)q * gthreads; if (i >= (size_t)2 * MROWS * 256 / 8) i = i0; a[q] = __builtin_nontemporal_load((const f32x4*)(p + i * 8)); b2[q] = __builtin_nontemporal_load((const f32x4*)(p + i * 8 + 4)); }
#pragma unroll
                for (int q = 0; q < 4; ++q) { const size_t i = i0 + (size_t)q * gthreads; if (i < (size_t)2 * MROWS * 256 / 8) {
                    u32x4 w; w.x = cvt_pk_bf16(a[q][0], a[q][1]); w.y = cvt_pk_bf16(a[q][2], a[q][3]); w.z = cvt_pk_bf16(b2[q][0], b2[q][1]); w.w = cvt_pk_bf16(b2[q][2], b2[q][3]); *(u32x4*)(PBF + i * 8) = w; } } }
            for (size_t i = gtid; i < (size_t)3 * MROWS; i += gthreads) RS[MROWS + i] = 0.f;
            for (size_t i = gtid; i < (size_t)8 * MROWS; i += gthreads) KSS[i] = 0.f;
        }
        if (EN_P2 && ph == 2) {
            u32x4 kw0[4], vw0[4], kw1[4], vw1[4], qw[4]; float ks0, ks1;
            for (int it = bid; it < 512; it += G) ret_contrib_item(lds, PROJ, ST, it, tid, wid, lane);
            float qgv[4][8];
#pragma unroll
            for (int ks = 0; ks < 4; ++ks)
#pragma unroll
                for (int j = 0; j < 8; ++j) qgv[ks][j] = q_g[32 * ks + 8 * (lane >> 4) + j] * k_g[32 * ks + 8 * (lane >> 4) + j];
            { const ARun R0 = attn_run(bid < 1024 ? bid : 1023);
              attn_load_half(PROJ, KSS, R0, 0, tid, kw0, vw0, ks0); attn_load_half(PROJ, KSS, R0, 1, tid, kw1, vw1, ks1); attn_load_q(PROJ, R0, 0, wid, lane, qw); }
            for (int rho = bid; rho < 1024; rho += G) { const ARun R = attn_run(rho); const ARun Rnext = attn_run(rho + G < 1024 ? rho + G : rho);
                for (int i = 0; i < R.len; ++i) { const bool last = (i + 1 == R.len);
                    attn_item(lds, PROJ, OG, LSE, KSS, qgv, R, i, last ? Rnext : R, last ? 0 : i + 1, last, kw0, vw0, ks0, kw1, vw1, ks1, qw, tid, wid, lane); } }
        }
        if (EN_P3 && ph == 3) {
            for (size_t i = gtid; i < (size_t)16 * 8192; i += gthreads) { const int bh = (int)(i >> 13), e4 = (int)(i & 8191); const float gc = __expf(ret_log_g(bh & 3) * 128.0f);
                const u16* sp = ST + (size_t)bh * 32 * 32768 + (size_t)e4 * 4; u16* rp = RT + (size_t)bh * 32 * 32768 + (size_t)e4 * 4;
                f32x4 R = {0.f, 0.f, 0.f, 0.f};
                for (int n0 = 0; n0 < 32; n0 += 8) { f32x4 sv[8];
#pragma unroll
                    for (int q = 0; q < 8; ++q) { const u32x2 w = __builtin_nontemporal_load((const u32x2*)(sp + (size_t)(n0 + q) * 32768)); sv[q] = (f32x4){bflo(w.x), bfhi(w.x), bflo(w.y), bfhi(w.y)}; }
#pragma unroll
                    for (int q = 0; q < 8; ++q) { u32x2 w; w.x = cvt_pk_bf16(R[0], R[1]); w.y = cvt_pk_bf16(R[2], R[3]); *(u32x2*)(rp + (size_t)(n0 + q) * 32768) = w; R = R * gc + sv[q]; } } }
        }
        if (EN_P4 && ph == 4) {
            auto merge_patterns = [&]() {
                __syncthreads();
                { auto dec = [=](int r) -> TJob { return TJob{w_in_o, WT_IN, pre_g + 2048, 2048, NO, r, 1}; }; transpose_run(dec, 32 * 128, (LAS float*)lds, bid, G, tid); }
            for (size_t i0 = gtid; i0 < (size_t)MROWS * 128; i0 += 4 * gthreads) {
                u32x4 w0[4], w1[4], w2[4], wz[4]; float l0[4], l1[4], l2[4];
#pragma unroll
                for (int q = 0; q < 4; ++q) { size_t i = i0 + (size_t)q * gthreads; if (i >= (size_t)MROWS * 128) i = i0; const size_t row = i >> 7; const int c8 = (int)(i & 127), h = c8 >> 4, col = c8 * 8;
                    l0[q] = LSE[row * 8 + h]; l1[q] = LSE[((size_t)MROWS + row) * 8 + h]; l2[q] = LSE[((size_t)2 * MROWS + row) * 8 + h];
                    w0[q] = __builtin_nontemporal_load((const u32x4*)(OG + row * 1024 + col)); w1[q] = __builtin_nontemporal_load((const u32x4*)(OG + ((size_t)MROWS + row) * 1024 + col));
                    w2[q] = __builtin_nontemporal_load((const u32x4*)(OG + ((size_t)2 * MROWS + row) * 1024 + col)); wz[q] = __builtin_nontemporal_load((const u32x4*)(PROJ + row * NE + 6144 + col)); }
#pragma unroll
                for (int q = 0; q < 4; ++q) { const size_t i = i0 + (size_t)q * gthreads; if (i < (size_t)MROWS * 128) { const size_t row = i >> 7; const int col = (int)(i & 127) * 8;
                    const float mm = fmaxf(l0[q], fmaxf(l1[q], l2[q])); float e0 = __expf(l0[q] - mm), e1 = __expf(l1[q] - mm), e2 = __expf(l2[q] - mm); const float inv = __builtin_amdgcn_rcpf(e0 + e1 + e2);
                    e0 *= inv; e1 *= inv; e2 *= inv;
                    float a0[8], a1[8], a2[8], zf[8], r[8];
                    unpack8(w0[q], a0); unpack8(w1[q], a1); unpack8(w2[q], a2); unpack8(wz[q], zf);
#pragma unroll
                    for (int j = 0; j < 8; ++j) r[j] = (e0 * a0[j] + e1 * a1[j] + e2 * a2[j]) * silu_f(zf[j]);
                    *(u32x4*)(XA + row * DM + 1024 + col) = pack8(r); } }
            }
            };
            if (bid & 1) merge_patterns();
            for (int it = bid; it < 512; it += G) ret_out_item(lds, PROJ, RT, gn_g, XA, it, tid, wid, lane);
            if (!(bid & 1)) merge_patterns();
        }
        for (int pass = 0; pass < 2; ++pass) {
        const bool both = (ph == 5 || ph == 9), resid_turn = both && ((pass == 0) == ((bid & 1) == 0));
        if (EN_GR && resid_turn) {
            const bool l1 = (ph == 9);
            if (l1) {
                const float* VS = (const float*)(PROJ + SIDE_OFF); const float* WS = VS + (size_t)256 * 4 * 2048;
                pg8::StaticOrder so0; so0.init(MROWS, DM, G, bid); pg8::Unit uu;
                for (int ui = 0; so0.next(ui, uu); ++ui) {
                    bool seen = false; { pg8::Unit up; for (int uj = 0; uj < ui; ++uj) { so0.next(uj, up); seen = seen || (up.pm == uu.pm); } }
                    if (seen) continue;
                    for (int i = tid; i < 4 * 2 * 512; i += 512) { const int c4 = (i & 511) * 4, fr = (i >> 9) & 1; const size_t b64 = (size_t)uu.pm * 4 + (i >> 10);
                        const bool first = (b64 & 63) == 0;
                        const f32x4 z4 = {0.f, 0.f, 0.f, 0.f};
                        const f32x4 v = *(const f32x4*)(VS + (b64 * 4 + fr) * 2048 + c4), wv = *(const f32x4*)(WS + (b64 * 2 + fr) * 2048 + c4);
                        f32x4 v1, v2;
                        if (fr == 0) { v1 = first ? z4 : *(const f32x4*)(VS + ((b64 - 1) * 4 + 3) * 2048 + c4); v2 = first ? z4 : *(const f32x4*)(VS + ((b64 - 1) * 4 + 2) * 2048 + c4); }
                        else { v1 = *(const f32x4*)(VS + (b64 * 4 + 0) * 2048 + c4); v2 = first ? z4 : *(const f32x4*)(VS + ((b64 - 1) * 4 + 3) * 2048 + c4); }
                        const f32x4 c0 = *(const f32x4*)(conv_w + c4), c1 = *(const f32x4*)(conv_w + 2048 + c4), c2 = *(const f32x4*)(conv_w + 4096 + c4);
                        const f32x4 y = wv * (c2 * v + c1 * v1 + c0 * v2);
                        u32x2 w; w.x = cvt_pk_bf16(y[0], y[1]); w.y = cvt_pk_bf16(y[2], y[3]); *(u32x2*)(XB + (b64 * 64 + fr) * DM + c4) = w; }
                }
                asm volatile("s_waitcnt vmcnt(0)" ::: "memory"); __syncthreads();
            }
            pg8::Gemm g{l1 ? XB : XA, l1 ? WT_O1 : WT_O0, MROWS, DM, 2048, 2048, 2048}; pg8::StaticOrder so; so.init(MROWS, DM, G, bid);
            if (l1) { pg8::EpiResid<false> e{nullptr, XA, XA, RS + 3 * MROWS}; pg8::gemm_phase<pg8::EpiResid<false>, pg8::StaticOrder, false>(lds, g, so, e, nullptr); }
            else { pg8::EpiResid<true> e{x, XA, XB, RS + 1 * MROWS}; pg8::gemm_phase<pg8::EpiResid<true>, pg8::StaticOrder, false>(lds, g, so, e, nullptr); }
        }
        if (EN_GS && ((both && !resid_turn) || (pass == 0 && (ph == 1 || ph == 7)))) {
            pg8::Gemm g; pg8::EpiScaleBf16 e; int N;
            if (ph == 1) { g = pg8::Gemm{XA, WT_IN, MROWS, NE, 2048, 2048, 2048}; e = pg8::EpiScaleBf16{PROJ, NE, RS, nullptr, nullptr, nullptr, KSS}; N = NE; }
            else if (ph == 7) { g = pg8::Gemm{XA, WT_IN, MROWS, NO, 2048, 2048, 2048}; e = pg8::EpiScaleBf16{XB, DM, RS + 2 * MROWS, conv_w, (float*)(PROJ + SIDE_OFF), (float*)(PROJ + SIDE_OFF) + (size_t)256 * 4 * 2048, nullptr}; N = NO; }
            else { const bool l1 = (ph == 9); g = pg8::Gemm{PBF + (l1 ? (size_t)MROWS * 256 : 0), l1 ? WT_P1 : WT_P0, MROWS, DM, 256, 256, 256}; e = pg8::EpiScaleBf16{PROJ, DM, nullptr, nullptr, nullptr, nullptr, nullptr}; N = DM; }
            pg8::StaticOrder so; so.init(MROWS, N, G, bid);
            pg8::gemm_phase<pg8::EpiScaleBf16, pg8::StaticOrder, false>(lds, g, so, e, nullptr);
        }
        }
        if (EN_GG && (ph == 6 || ph == 10)) {
            const bool l1 = (ph == 10);
            pg8::Gemm g{l1 ? XA : XB, l1 ? WT_G1 : WT_G0, MROWS, DM, 2048, 2048, 2048}; pg8::StaticOrder so; so.init(MROWS, DM, G, bid);
            pg8::EpiGate e{RS + (l1 ? 3 : 1) * MROWS, PROJ, l1 ? XA : XB, XA, l1 ? out : (float*)nullptr, RS + 2 * MROWS};
            pg8::gemm_phase<pg8::EpiGate, pg8::StaticOrder, false>(lds, g, so, e, nullptr);
        }
        if (step + 1 < P.nsched) { if (step == 0) { grid.sync(); xb = xcd_barrier_post(xb_words, xb_st); } else xcd_barrier(xb); }
    }
}

extern "C" void kernel_launch(void* const* d_in, const int* in_sizes, int n_in, void* d_out, int out_size, void* d_ws, size_t ws_size, hipStream_t stream) {
    static int grid = 0;
    if (grid == 0) {
        if (n_in != 14 || out_size != MROWS * DM || ws_size < WS_END) { fprintf(stderr, "kernel_launch: unexpected shapes (n_in %d out %d ws %zu need %zu)\n", n_in, out_size, ws_size, (size_t)WS_END); grid = -1; return; }
        int dev = 0, cus = 0, per_cu = 0;
        hipGetDevice(&dev); hipDeviceGetAttribute(&cus, hipDeviceAttributeMultiprocessorCount, dev);
        if (hipFuncSetAttribute((const void*)hybrid_fwd, hipFuncAttributeMaxDynamicSharedMemorySize, LDS_BYTES) != hipSuccess) { fprintf(stderr, "kernel_launch: hipFuncSetAttribute failed\n"); grid = -1; return; }
        if (hipOccupancyMaxActiveBlocksPerMultiprocessor(&per_cu, (const void*)hybrid_fwd, 512, LDS_BYTES) != hipSuccess || per_cu < 1) { fprintf(stderr, "kernel_launch: occupancy query says %d\n", per_cu); (void)hipGetLastError(); per_cu = 1; }
        grid = cus * per_cu;
    }
    if (grid < 0) return;
    Params P{};
    for (int i = 0; i < 14; ++i) P.in[i] = (const float*)d_in[i];
    P.out = (float*)d_out; P.ws = (unsigned char*)d_ws; P.sched = SCHED_BITS; P.nsched = SCHED_N;
    void* args[] = {&P};
    hipError_t e = hipLaunchCooperativeKernel((const void*)hybrid_fwd, dim3(grid), dim3(512), args, LDS_BYTES, stream);
    if (e != hipSuccess) fprintf(stderr, "cooperative launch failed: %s (grid %d)\n", hipGetErrorString(e), grid);
}
```
